# Optimizing an MI355X kernel written in HIP

```python
import jax
import jax.numpy as jnp
from jax import lax
import numpy as np

D_MODEL = 1024
BATCH = 2
SEQ = 16384
DEPTH = 2

N_MIXERS = 2
N_META = 16
BLOCK = 128
EPS = 1e-6
NEG_INF = -1e30

FOX_HEADS = 16
FOX_HEAD_DIM = D_MODEL // FOX_HEADS
FOX_IN = 3 * D_MODEL + FOX_HEADS
FOX_FORGET_BIAS = 2.0

HG_HEADS = 8
HG_KEY_DIM = 128
HG_VAL_DIM = D_MODEL // HG_HEADS
HG_KEY_TOTAL = HG_HEADS * HG_KEY_DIM
HG_IN = 2 * HG_KEY_TOTAL + 2 * D_MODEL

N_GROUPS = 4
EXPERTS_PER_GROUP = 8
N_EXPERTS = N_GROUPS * EXPERTS_PER_GROUP
TOP_K = 2
D_EXPERT = D_MODEL // 2
EXPERT_ROW_BLOCK = 128

kernel_name = 'hybrid_fox_hgrn2_hmoe'


def rms_norm(x, gain):
    xf = x.astype(jnp.float32)
    y = xf * lax.rsqrt(jnp.mean(xf * xf, axis=-1, keepdims=True) + EPS)
    return (y * gain.astype(jnp.float32)).astype(x.dtype)


def front_pad(t, pad):
    widths = [(0, 0)] * t.ndim
    widths[1] = (pad, 0)
    return jnp.pad(t, widths)


def fox_attention(h, w_in, b_f, g_q, g_k, w_out):
    bsz, length, _ = h.shape
    q, k, v, f_logit = jnp.split(h @ w_in, [D_MODEL, 2 * D_MODEL, 3 * D_MODEL], axis=-1)
    q = rms_norm(q.reshape(bsz, length, FOX_HEADS, FOX_HEAD_DIM), g_q)
    k = rms_norm(k.reshape(bsz, length, FOX_HEADS, FOX_HEAD_DIM), g_k)
    v = v.reshape(bsz, length, FOX_HEADS, FOX_HEAD_DIM)
    log_f = jax.nn.log_sigmoid(f_logit.astype(jnp.float32) + b_f.astype(jnp.float32))
    pad = (-length) % BLOCK
    q, k, v, log_f = (front_pad(t, pad) for t in (q, k, v, log_f))
    lp = length + pad
    n_blk = lp // BLOCK
    cum = jnp.cumsum(log_f, axis=1).transpose(0, 2, 1)
    kh = k.transpose(0, 2, 1, 3)
    vh = v.transpose(0, 2, 1, 3)
    qb = q.reshape(bsz, n_blk, BLOCK, FOX_HEADS, FOX_HEAD_DIM).transpose(1, 0, 3, 2, 4)
    cb = cum.reshape(bsz, FOX_HEADS, n_blk, BLOCK).transpose(2, 0, 1, 3)
    key_pos = jnp.arange(lp)
    key_ok = key_pos >= pad
    scale = FOX_HEAD_DIM ** -0.5

    def attend(args):
        qi, ci, bi = args
        s = jnp.einsum('bhqd,bhkd->bhqk', qi, kh).astype(jnp.float32) * scale
        s = s + ci[..., :, None] - cum[:, :, None, :]
        q_pos = bi * BLOCK + jnp.arange(BLOCK)
        mask = (key_pos[None, :] <= q_pos[:, None]) & key_ok[None, :]
        p = jax.nn.softmax(jnp.where(mask, s, NEG_INF), axis=-1)
        return jnp.einsum('bhqk,bhkd->bhqd', p.astype(vh.dtype), vh)

    o = lax.map(attend, (qb, cb, jnp.arange(n_blk)))
    o = o.transpose(1, 0, 3, 2, 4).reshape(bsz, lp, D_MODEL)[:, pad:]
    return o @ w_out


def hgrn_lower_bounds(lb_logits):
    p = jax.nn.softmax(lb_logits.astype(jnp.float32), axis=0)
    cum = jnp.cumsum(p, axis=0)
    return cum - cum[:1]


def hgrn2_recurrence(h, w_in, b_f, lower_bound, g_o, w_out):
    bsz, length, _ = h.shape
    q, f_logit, v, g = jnp.split(
        h @ w_in, [HG_KEY_TOTAL, 2 * HG_KEY_TOTAL, 2 * HG_KEY_TOTAL + D_MODEL], axis=-1)
    f = lower_bound + (1.0 - lower_bound) * jax.nn.sigmoid(
        f_logit.astype(jnp.float32) + b_f.astype(jnp.float32))
    log_f = jnp.log(f)
    k = 1.0 - f
    q = jax.nn.silu(q.astype(jnp.float32))
    v = v.astype(jnp.float32)
    pad = (-length) % BLOCK
    lp = length + pad
    n_chk = lp // BLOCK

    def to_chunks(t, d):
        t = front_pad(t, pad).reshape(bsz, n_chk, BLOCK, HG_HEADS, d)
        return t.transpose(1, 0, 3, 2, 4)

    qc = to_chunks(q, HG_KEY_DIM)
    kc = to_chunks(k, HG_KEY_DIM)
    vc = to_chunks(v, HG_VAL_DIM)
    lc = to_chunks(log_f, HG_KEY_DIM)
    causal = jnp.tril(jnp.ones((BLOCK, BLOCK), dtype=bool))

    def step(state, args):
        qi, ki, vi, li = args
        b = jnp.cumsum(li, axis=2)
        o_inter = jnp.einsum('bhtk,bhkv->bhtv', qi * jnp.exp(b), state)
        diff = b[:, :, :, None, :] - b[:, :, None, :, :]
        decay = jnp.exp(jnp.where(causal[:, :, None], diff, -jnp.inf))
        scores = jnp.einsum('bhtk,bhsk,bhtsk->bhts', qi, ki, decay)
        o_intra = jnp.einsum('bhts,bhsv->bhtv', scores, vi)
        b_end = b[:, :, -1:, :]
        state = (jnp.exp(b_end[:, :, 0, :])[..., None] * state
                 + jnp.einsum('bhsk,bhsv->bhkv', ki * jnp.exp(b_end - b), vi))
        return state, o_inter + o_intra

    s0 = jnp.zeros((bsz, HG_HEADS, HG_KEY_DIM, HG_VAL_DIM), jnp.float32)
    _, o = lax.scan(step, s0, (qc, kc, vc, lc))
    o = o.transpose(1, 0, 3, 2, 4).reshape(bsz, lp, HG_HEADS, HG_VAL_DIM)[:, pad:]
    o = rms_norm(o, g_o).reshape(bsz, length, D_MODEL) * jax.nn.silu(g.astype(jnp.float32))
    return o.astype(h.dtype) @ w_out


def hier_moe(h, w_grp, b_grp, w_rt, b_rt, w_up, w_down):
    bsz, length, dm = h.shape
    n_tok = bsz * length
    n_asg = n_tok * TOP_K
    xt = h.reshape(n_tok, dm)
    g_prob = jax.nn.softmax((xt @ w_grp).astype(jnp.float32) + b_grp.astype(jnp.float32), axis=-1)
    g_gate, g_idx = lax.top_k(g_prob, 1)
    e_logit = ((xt @ w_rt).astype(jnp.float32) + b_rt.astype(jnp.float32)).reshape(
        n_tok, N_GROUPS, EXPERTS_PER_GROUP)
    e_logit = jnp.take_along_axis(e_logit, g_idx[:, :, None], axis=1)[:, 0]
    e_val, e_idx = lax.top_k(e_logit, TOP_K)
    gate = jax.nn.softmax(e_val, axis=-1) * g_gate
    expert = (g_idx * EXPERTS_PER_GROUP + e_idx).reshape(-1)
    order = jnp.argsort(expert)
    se = expert[order]
    tok = order // TOP_K
    w_sorted = gate.reshape(-1)[order]
    counts = jnp.bincount(expert, length=N_EXPERTS)
    padded = (counts + EXPERT_ROW_BLOCK - 1) // EXPERT_ROW_BLOCK * EXPERT_ROW_BLOCK
    start = jnp.cumsum(counts) - counts
    pend = jnp.cumsum(padded)
    pstart = pend - padded
    dest = pstart[se] + jnp.arange(n_asg) - start[se]
    n_blocks = (n_asg + N_EXPERTS * (EXPERT_ROW_BLOCK - 1) + EXPERT_ROW_BLOCK - 1) // EXPERT_ROW_BLOCK
    rows = n_blocks * EXPERT_ROW_BLOCK
    x_pad = jnp.zeros((rows, dm), h.dtype).at[dest].set(xt[tok])
    block_expert = jnp.minimum(
        jnp.searchsorted(pend, jnp.arange(n_blocks) * EXPERT_ROW_BLOCK, side='right'), N_EXPERTS - 1)

    def expert_block(args):
        xb, e = args
        gate_up = xb @ w_up[e]
        a, u = jnp.split(gate_up, 2, axis=-1)
        return (jax.nn.silu(a) * u) @ w_down[e]

    y_pad = lax.map(expert_block, (x_pad.reshape(n_blocks, EXPERT_ROW_BLOCK, dm), block_expert))
    y = y_pad.reshape(rows, dm)[dest] * w_sorted[:, None].astype(h.dtype)
    return jnp.zeros_like(xt).at[tok].add(y).reshape(bsz, length, dm)


def setup_inputs(seed: int = 0) -> dict:
    key = jax.random.key(seed)
    ks = jax.random.split(key, 24)
    n_fox = (DEPTH + N_MIXERS - 1) // N_MIXERS
    n_hg = DEPTH // N_MIXERS
    out_scale = (2 * DEPTH) ** -0.5

    def nrm(k, shape, scale):
        return jax.random.normal(k, shape, jnp.float32) * scale

    def gain(k, shape):
        return 1.0 + nrm(k, shape, 0.02)

    return {
        'x': nrm(ks[0], (BATCH, SEQ, D_MODEL), 1.0),
        'meta_tokens': nrm(ks[1], (N_META, D_MODEL), 1.0),
        'fox_norm': gain(ks[2], (n_fox, D_MODEL)),
        'fox_w_in': nrm(ks[3], (n_fox, D_MODEL, FOX_IN), D_MODEL ** -0.5),
        'fox_b_f': FOX_FORGET_BIAS + nrm(ks[4], (n_fox, FOX_HEADS), 0.1),
        'fox_q_norm': gain(ks[5], (n_fox, FOX_HEAD_DIM)),
        'fox_k_norm': gain(ks[6], (n_fox, FOX_HEAD_DIM)),
        'fox_w_out': nrm(ks[7], (n_fox, D_MODEL, D_MODEL), D_MODEL ** -0.5 * out_scale),
        'hg_norm': gain(ks[8], (n_hg, D_MODEL)),
        'hg_w_in': nrm(ks[9], (n_hg, D_MODEL, HG_IN), D_MODEL ** -0.5),
        'hg_b_f': nrm(ks[10], (n_hg, HG_KEY_TOTAL), 0.02),
        'hg_lb_logits': nrm(ks[11], (DEPTH, HG_KEY_TOTAL), 0.5),
        'hg_o_norm': gain(ks[12], (n_hg, HG_VAL_DIM)),
        'hg_w_out': nrm(ks[13], (n_hg, D_MODEL, D_MODEL), D_MODEL ** -0.5 * out_scale),
        'moe_norm': gain(ks[14], (DEPTH, D_MODEL)),
        'moe_w_grp': nrm(ks[15], (DEPTH, D_MODEL, N_GROUPS), D_MODEL ** -0.5),
        'moe_b_grp': nrm(ks[16], (DEPTH, N_GROUPS), 0.01),
        'moe_w_rt': nrm(ks[17], (DEPTH, D_MODEL, N_EXPERTS), D_MODEL ** -0.5),
        'moe_b_rt': nrm(ks[18], (DEPTH, N_EXPERTS), 0.01),
        'moe_w_up': nrm(ks[19], (DEPTH, N_EXPERTS, D_MODEL, 2 * D_EXPERT), D_MODEL ** -0.5),
        'moe_w_down': nrm(ks[20], (DEPTH, N_EXPERTS, D_EXPERT, D_MODEL), D_EXPERT ** -0.5 * out_scale),
    }


def reference(x, meta_tokens, fox_norm, fox_w_in, fox_b_f, fox_q_norm, fox_k_norm, fox_w_out,
              hg_norm, hg_w_in, hg_b_f, hg_lb_logits, hg_o_norm, hg_w_out,
              moe_norm, moe_w_grp, moe_b_grp, moe_w_rt, moe_b_rt, moe_w_up, moe_w_down):
    bsz = x.shape[0]
    meta = jnp.broadcast_to(meta_tokens[None].astype(x.dtype), (bsz, N_META, D_MODEL))
    h = jnp.concatenate([meta, x], axis=1)
    lower_bounds = hgrn_lower_bounds(hg_lb_logits)
    for i in range(DEPTH):
        j = i // N_MIXERS
        if i % N_MIXERS == 0:
            h = h + fox_attention(rms_norm(h, fox_norm[j]), fox_w_in[j], fox_b_f[j],
                                  fox_q_norm[j], fox_k_norm[j], fox_w_out[j])
        else:
            h = h + hgrn2_recurrence(rms_norm(h, hg_norm[j]), hg_w_in[j], hg_b_f[j],
                                     lower_bounds[i], hg_o_norm[j], hg_w_out[j])
        h = h + hier_moe(rms_norm(h, moe_norm[i]), moe_w_grp[i], moe_b_grp[i],
                         moe_w_rt[i], moe_b_rt[i], moe_w_up[i], moe_w_down[i])
    return h[:, N_META:]
```

```cpp
#include <hip/hip_runtime.h>
#include <cstdio>
#include <cstdint>
namespace pg8 {
#define PG8_LAS __attribute__((address_space(3)))
typedef unsigned short bf16_t;
typedef short bf16x8 __attribute__((ext_vector_type(8)));
typedef float f32x4 __attribute__((ext_vector_type(4)));
typedef unsigned u32x4 __attribute__((ext_vector_type(4)));
constexpr int BM = 256, BK = 64, HALF = 128, HTB = HALF * BK * 2  , STAGE_BYTES = 8 * HTB, NXCD = 8, WGM = 8;

__host__ __device__ __forceinline__ int lds_byte(int r, int c) { const int st = (r >> 4) * 2 + (c >> 5), rr = r & 15, cc = c & 31, ob = rr * 64 + cc * 2; return st * 1024 + (ob ^ (((ob >> 9) & 1) << 5)); }
__host__ __device__ __forceinline__ void stage_rc(int b, int& R, int& C) { const int st = b / 1024, sb = b % 1024, swz = sb ^ (((sb >> 9) & 1) << 5); R = (st >> 1) * 16 + swz / 64; C = (st & 1) * 32 + (swz % 64) / 2; }
__host__ __device__ __forceinline__ int perm32(int rho) { const int n = rho >> 4, i = rho & 15; return 8 * (i >> 2) + 4 * n + (i & 3); }

struct Unit { int pm, pn, ord; };
struct Gemm { const bf16_t* A; const bf16_t* Bt; int M, N, K; };

struct StaticOrder {
    int nM, nN, nwg, G, c;
    __host__ __device__ void init(int M, int N, int G_, int c_) { nM = M / BM; nN = N / BM; nwg = nM * nN; G = G_; c = c_; }
    __host__ __device__ bool next(int i, Unit& u) const {
        const long L = (long)i * G + c; if (L >= nwg) return false;
        int wgid = (int)L; { const int q = nwg / NXCD, r = nwg % NXCD, xcd = wgid % NXCD, off = wgid / NXCD; wgid = (xcd < r ? xcd * (q + 1) : r * (q + 1) + (xcd - r) * q) + off; }
        const int nig = WGM * nN, gid = wgid / nig, fm = gid * WGM, gsz = (nM - fm) < WGM ? (nM - fm) : WGM;
        u.pm = fm + ((wgid % nig) % gsz); u.pn = (wgid % nig) / gsz; u.ord = i; return true;
    }
    __device__ __forceinline__ void a_ready(const Unit&) const {}
    __device__ __forceinline__ void done(const Unit&) const {}
};
__device__ __forceinline__ unsigned cvt_pk_bf16(float lo, float hi) { unsigned r; asm volatile("v_cvt_pk_bf16_f32 %0, %1, %2" : "=v"(r) : "v"(lo), "v"(hi)); return r; }
typedef float f32x2 __attribute__((ext_vector_type(2)));
template <class Epi, class Sched, bool ALIGN_EPI = false, bool SP2 = false>
__device__ __forceinline__ void gemm_phase(PG8_LAS unsigned char* lds, const Gemm g, const Sched& S, const Epi& E) {
    const int tid = threadIdx.x, wid = __builtin_amdgcn_readfirstlane(tid >> 6), lane = tid & 63, wr = wid >> 2, wc = wid & 3, fr = lane & 15, fq = lane >> 4;
    const int K = g.K, nt = K / BK;
    unsigned voffA[2], voffB[2];
#pragma unroll
    for (int i = 0; i < 2; ++i) { int R, C; stage_rc(tid * 16 + i * 8192, R, C); const int Rb = Epi::PERM ? ((R & ~31) + perm32(R & 31)) : R;
        voffA[i] = (unsigned)(R * K + C) * 2u; voffB[i] = (unsigned)(Rb * K + C) * 2u; }
    const size_t kstep = (size_t)(BK * 2);
    const size_t hstep = (size_t)HALF * K * 2;
    const size_t tstep = 2 * hstep;
    const unsigned ldsw = (unsigned)wid * 1024u;
    const int aoff = lds_byte(wr * 64 + fr, fq * 8), boff = lds_byte(wc * 32 + fr, fq * 8);
#define PG8_SA(b, h) (((b) * 2 + (h)) * HTB)
#define PG8_SB(b, h) ((4 + (b) * 2 + (h)) * HTB)
#define PG8_STAGE(bufoff, gbase, voff) do { _Pragma("unroll") for (int _i = 0; _i < 2; ++_i) \
        __builtin_amdgcn_global_load_lds((const unsigned*)((const char*)(gbase) + (voff)[_i]), (PG8_LAS unsigned*)(lds + (bufoff) + ldsw + _i * 8192), 16, 0, 0); } while (0)
#define PG8_LDA(dst, b, h) do { _Pragma("unroll") for (int m = 0; m < 4; ++m) _Pragma("unroll") for (int k = 0; k < 2; ++k) dst[m][k] = *(const PG8_LAS bf16x8*)(lds + PG8_SA(b, h) + aoff + m * 2048 + k * 1024); } while (0)
#define PG8_LDB(dst, b, h) do { _Pragma("unroll") for (int n = 0; n < 2; ++n) _Pragma("unroll") for (int k = 0; k < 2; ++k) dst[n][k] = *(const PG8_LAS bf16x8*)(lds + PG8_SB(b, h) + boff + n * 2048 + k * 1024); } while (0)
#define PG8_MMA(ai, bj, At, Bt) do { __builtin_amdgcn_s_setprio(1); _Pragma("unroll") for (int m = 0; m < 4; ++m) _Pragma("unroll") for (int n = 0; n < 2; ++n) _Pragma("unroll") for (int k = 0; k < 2; ++k) \
        acc[ai][bj][m][n] = __builtin_amdgcn_mfma_f32_16x16x32_bf16(Bt[n][k], At[m][k], acc[ai][bj][m][n], 0, 0, 0); __builtin_amdgcn_s_setprio(0); } while (0)
#define PG8_WAIT_V(n) asm volatile("s_waitcnt vmcnt(" #n ")" ::: "memory")
#define PG8_WAIT_L(n) asm volatile("s_waitcnt lgkmcnt(" #n ")" ::: "memory")
#define PG8_BAR __builtin_amdgcn_s_barrier()
#define PG8_SCHED __builtin_amdgcn_sched_barrier(0)
    Unit cur, nxt; int ui = 0;
    if (!S.next(0, cur)) return;
    f32x4 acc[2][2][4][2];
#pragma unroll
    for (int a = 0; a < 2; ++a)
#pragma unroll
        for (int b = 0; b < 2; ++b)
#pragma unroll
            for (int m = 0; m < 4; ++m)
#pragma unroll
                for (int n = 0; n < 2; ++n) acc[a][b][m][n] = (f32x4){0.f, 0.f, 0.f, 0.f};
    bf16x8 At[4][2], B0[2][2], B1[2][2];
    const char* cA = (const char*)g.A + (size_t)cur.pm * tstep; const char* cB = (const char*)g.Bt + (size_t)cur.pn * tstep;
    S.a_ready(cur);
    if constexpr (SP2) {
        PG8_STAGE(PG8_SB(0, 0), cB, voffB); PG8_STAGE(PG8_SB(0, 1), cB + hstep, voffB); PG8_STAGE(PG8_SA(0, 0), cA, voffA); PG8_STAGE(PG8_SA(0, 1), cA + hstep, voffA);
        if (wr == 1) PG8_BAR;
        PG8_WAIT_V(2); PG8_BAR;
        PG8_STAGE(PG8_SB(1, 0), cB + kstep, voffB); PG8_STAGE(PG8_SA(1, 0), cA + kstep, voffA); PG8_STAGE(PG8_SB(1, 1), cB + hstep + kstep, voffB);
        PG8_WAIT_V(6); PG8_BAR;
    } else {
        PG8_STAGE(PG8_SB(0, 0), cB, voffB); PG8_STAGE(PG8_SA(0, 0), cA, voffA); PG8_STAGE(PG8_SB(0, 1), cB + hstep, voffB); PG8_STAGE(PG8_SA(0, 1), cA + hstep, voffA);
        if (wr == 1) PG8_BAR;
        PG8_WAIT_V(4); PG8_BAR;
        PG8_STAGE(PG8_SB(1, 0), cB + kstep, voffB); PG8_STAGE(PG8_SA(1, 0), cA + kstep, voffA); PG8_STAGE(PG8_SB(1, 1), cB + hstep + kstep, voffB);
        PG8_WAIT_V(6); PG8_BAR;
    }
    for (;;) {
        const bool has_next = S.next(ui + 1, nxt);
        const char* nA = has_next ? (const char*)g.A + (size_t)nxt.pm * tstep : cA; const char* nB = has_next ? (const char*)g.Bt + (size_t)nxt.pn * tstep : cB;
        for (int t = 0; t < nt; t += 2) {
            const bool last = (t == nt - 2);
            const char* a1 = cA + (size_t)(t + 1) * kstep;
            const char* a2 = last ? nA : cA + (size_t)(t + 2) * kstep; const char* b2 = last ? nB : cB + (size_t)(t + 2) * kstep;
            const char* a3 = a2 + kstep; const char* b3 = b2 + kstep;
            if (last && has_next) S.a_ready(nxt);
            if constexpr (SP2) {
            PG8_LDB(B0, 0, 0); PG8_LDB(B1, 0, 1); PG8_SCHED; PG8_LDA(At, 0, 0); PG8_STAGE(PG8_SA(1, 1), a1 + hstep, voffA);
            PG8_WAIT_V(8); PG8_WAIT_L(0); PG8_BAR; PG8_MMA(0, 0, At, B0); PG8_MMA(0, 1, At, B1); PG8_BAR; PG8_SCHED;
            PG8_LDA(At, 0, 1); PG8_STAGE(PG8_SB(0, 0), b2, voffB); PG8_STAGE(PG8_SB(0, 1), b2 + hstep, voffB); PG8_STAGE(PG8_SA(0, 0), a2, voffA);
            PG8_WAIT_V(8); PG8_WAIT_L(0); PG8_BAR; PG8_MMA(1, 0, At, B0); PG8_MMA(1, 1, At, B1); PG8_BAR; PG8_SCHED;
            PG8_LDB(B0, 1, 0); PG8_LDB(B1, 1, 1); PG8_SCHED; PG8_LDA(At, 1, 0); PG8_STAGE(PG8_SA(0, 1), a2 + hstep, voffA);
            PG8_WAIT_V(8); PG8_WAIT_L(0); PG8_BAR; PG8_MMA(0, 0, At, B0); PG8_MMA(0, 1, At, B1); PG8_BAR; PG8_SCHED;
            PG8_LDA(At, 1, 1); PG8_STAGE(PG8_SB(1, 0), b3, voffB); PG8_STAGE(PG8_SB(1, 1), b3 + hstep, voffB); PG8_STAGE(PG8_SA(1, 0), a3, voffA);
            PG8_WAIT_V(8); PG8_WAIT_L(0); PG8_BAR; PG8_MMA(1, 0, At, B0); PG8_MMA(1, 1, At, B1); PG8_BAR; PG8_SCHED;
            } else {
            PG8_LDB(B0, 0, 0); PG8_SCHED; PG8_LDA(At, 0, 0); PG8_STAGE(PG8_SA(1, 1), a1 + hstep, voffA);
            PG8_WAIT_L(8); PG8_BAR; PG8_WAIT_L(0); PG8_MMA(0, 0, At, B0); PG8_BAR; PG8_SCHED;
            PG8_LDB(B1, 0, 1); PG8_STAGE(PG8_SB(0, 0), b2, voffB);
            PG8_BAR; PG8_WAIT_L(0); PG8_MMA(0, 1, At, B1); PG8_BAR;
            PG8_LDA(At, 0, 1); PG8_STAGE(PG8_SA(0, 0), a2, voffA);
            PG8_BAR; PG8_WAIT_L(0); PG8_MMA(1, 0, At, B0); PG8_BAR; PG8_SCHED;
            PG8_STAGE(PG8_SB(0, 1), b2 + hstep, voffB);
            PG8_WAIT_V(6); PG8_BAR; PG8_MMA(1, 1, At, B1); PG8_BAR;
            PG8_LDB(B0, 1, 0); PG8_SCHED; PG8_LDA(At, 1, 0); PG8_STAGE(PG8_SA(0, 1), a2 + hstep, voffA);
            PG8_WAIT_L(8); PG8_BAR; PG8_WAIT_L(0); PG8_MMA(0, 0, At, B0); PG8_BAR; PG8_SCHED;
            PG8_LDB(B1, 1, 1); PG8_STAGE(PG8_SB(1, 0), b3, voffB);
            PG8_BAR; PG8_WAIT_L(0); PG8_MMA(0, 1, At, B1); PG8_BAR;
            PG8_LDA(At, 1, 1); PG8_STAGE(PG8_SA(1, 0), a3, voffA);
            PG8_BAR; PG8_WAIT_L(0); PG8_MMA(1, 0, At, B0); PG8_BAR; PG8_SCHED;
            PG8_STAGE(PG8_SB(1, 1), b3 + hstep, voffB);
            PG8_WAIT_V(6); PG8_BAR; PG8_MMA(1, 1, At, B1); PG8_BAR;
            }
        }
        if constexpr (ALIGN_EPI) { if (wr == 0) PG8_BAR; }
        if constexpr (!Epi::AFTER_DRAIN) { E(acc, cur, wr, wc, fr, fq); S.done(cur); }
        if (!has_next) break;
#pragma unroll
        for (int a = 0; a < 2; ++a)
#pragma unroll
            for (int b = 0; b < 2; ++b)
#pragma unroll
                for (int m = 0; m < 4; ++m)
#pragma unroll
                    for (int n = 0; n < 2; ++n) acc[a][b][m][n] = (f32x4){0.f, 0.f, 0.f, 0.f};
        cur = nxt; cA = nA; cB = nB; ++ui;
        if constexpr (ALIGN_EPI) { if (wr == 1) PG8_BAR; }
    }
    PG8_WAIT_V(0);
    if constexpr (!ALIGN_EPI) { if (wr == 0) PG8_BAR; }
    PG8_BAR;
    if constexpr (Epi::AFTER_DRAIN) { E.fused(acc, cur, wr, wc, fr, fq, lds, wid, lane); S.done(cur); }
#undef PG8_SA
#undef PG8_SB
#undef PG8_STAGE
#undef PG8_LDA
#undef PG8_LDB
#undef PG8_MMA
#undef PG8_WAIT_V
#undef PG8_WAIT_L
#undef PG8_BAR
#undef PG8_SCHED
}
}
namespace pg8 {
template <class Epi, class Sched>
__device__ __forceinline__ void gemm_phase_g(PG8_LAS unsigned char* lds, const Gemm g, const Sched& S, const Epi& E, const PG8_LAS int* ridx) {
    const int tid = threadIdx.x, wid = __builtin_amdgcn_readfirstlane(tid >> 6), lane = tid & 63, wr = wid >> 2, wc = wid & 3, fr = lane & 15, fq = lane >> 4;
    const int K = g.K, nt = K / BK;
    int RA[2], CA[2]; unsigned voffB[2];
#pragma unroll
    for (int i = 0; i < 2; ++i) { int R, C; stage_rc(tid * 16 + i * 8192, R, C); const int Rb = Epi::PERM ? ((R & ~31) + perm32(R & 31)) : R;
        RA[i] = R; CA[i] = C * 2; voffB[i] = (unsigned)(Rb * K + C) * 2u; }
    const size_t kstep = (size_t)(BK * 2);
    const size_t hstep = (size_t)HALF * K * 2;
    const size_t tstep = 2 * hstep;
    const unsigned ldsw = (unsigned)wid * 1024u;
    const int aoff = lds_byte(wr * 64 + fr, fq * 8), boff = lds_byte(wc * 32 + fr, fq * 8);
#define PG8_SA(b, h) (((b) * 2 + (h)) * HTB)
#define PG8_SB(b, h) ((4 + (b) * 2 + (h)) * HTB)
#define PG8_STAGE(bufoff, gbase, voff) do { _Pragma("unroll") for (int _i = 0; _i < 2; ++_i) \
        __builtin_amdgcn_global_load_lds((const unsigned*)((const char*)(gbase) + (voff)[_i]), (PG8_LAS unsigned*)(lds + (bufoff) + ldsw + _i * 8192), 16, 0, 0); } while (0)
#define PG8_LDA(dst, b, h) do { _Pragma("unroll") for (int m = 0; m < 4; ++m) _Pragma("unroll") for (int k = 0; k < 2; ++k) dst[m][k] = *(const PG8_LAS bf16x8*)(lds + PG8_SA(b, h) + aoff + m * 2048 + k * 1024); } while (0)
#define PG8_LDB(dst, b, h) do { _Pragma("unroll") for (int n = 0; n < 2; ++n) _Pragma("unroll") for (int k = 0; k < 2; ++k) dst[n][k] = *(const PG8_LAS bf16x8*)(lds + PG8_SB(b, h) + boff + n * 2048 + k * 1024); } while (0)
#define PG8_MMA(ai, bj, At, Bt) do { __builtin_amdgcn_s_setprio(1); _Pragma("unroll") for (int m = 0; m < 4; ++m) _Pragma("unroll") for (int n = 0; n < 2; ++n) _Pragma("unroll") for (int k = 0; k < 2; ++k) \
        acc[ai][bj][m][n] = __builtin_amdgcn_mfma_f32_16x16x32_bf16(Bt[n][k], At[m][k], acc[ai][bj][m][n], 0, 0, 0); __builtin_amdgcn_s_setprio(0); } while (0)
#define PG8_WAIT_V(n) asm volatile("s_waitcnt vmcnt(" #n ")" ::: "memory")
#define PG8_WAIT_L(n) asm volatile("s_waitcnt lgkmcnt(" #n ")" ::: "memory")
#define PG8_BAR __builtin_amdgcn_s_barrier()
#define PG8_SCHED __builtin_amdgcn_sched_barrier(0)
#define PG8_GOFF(dst, ui_) do { _Pragma("unroll") for (int h_ = 0; h_ < 2; ++h_) _Pragma("unroll") for (int i_ = 0; i_ < 2; ++i_) \
        dst[h_][i_] = (unsigned)ridx[(ui_) * 256 + h_ * HALF + RA[i_]] * (unsigned)(K * 2) + (unsigned)CA[i_]; } while (0)
    Unit cur, nxt; int ui = 0, pend = -1;
    if (!S.next(0, cur)) return;
    f32x4 acc[2][2][4][2];
#pragma unroll
    for (int a = 0; a < 2; ++a)
#pragma unroll
        for (int b = 0; b < 2; ++b)
#pragma unroll
            for (int m = 0; m < 4; ++m)
#pragma unroll
                for (int n = 0; n < 2; ++n) acc[a][b][m][n] = (f32x4){0.f, 0.f, 0.f, 0.f};
    bf16x8 At[4][2], B0[2][2], B1[2][2];
    const char* gA = (const char*)g.A; const char* cB = (const char*)g.Bt + (size_t)cur.pn * tstep;
    unsigned vC[2][2], vN[2][2];
    PG8_GOFF(vC, 0);
    S.a_ready(cur);
    PG8_STAGE(PG8_SB(0, 0), cB, voffB); PG8_STAGE(PG8_SB(0, 1), cB + hstep, voffB); PG8_STAGE(PG8_SA(0, 0), gA, vC[0]); PG8_STAGE(PG8_SA(0, 1), gA, vC[1]);
    if (wr == 1) PG8_BAR;
    PG8_WAIT_V(2); PG8_BAR;
    PG8_STAGE(PG8_SB(1, 0), cB + kstep, voffB); PG8_STAGE(PG8_SA(1, 0), gA + kstep, vC[0]); PG8_STAGE(PG8_SB(1, 1), cB + hstep + kstep, voffB);
    PG8_WAIT_V(6); PG8_BAR;
    for (;;) {
        const bool has_next = S.next(ui + 1, nxt);
        const char* nB = has_next ? (const char*)g.Bt + (size_t)nxt.pn * tstep : cB;
        if (has_next) { PG8_GOFF(vN, ui + 1); } else {
#pragma unroll
            for (int h_ = 0; h_ < 2; ++h_)
#pragma unroll
                for (int i_ = 0; i_ < 2; ++i_) vN[h_][i_] = vC[h_][i_]; }
        for (int t = 0; t < nt; t += 2) {
            const bool last = (t == nt - 2);
            const char* a1 = gA + (size_t)(t + 1) * kstep;
            const char* a2 = last ? gA : gA + (size_t)(t + 2) * kstep; const char* b2 = last ? nB : cB + (size_t)(t + 2) * kstep;
            const char* a3 = a2 + kstep; const char* b3 = b2 + kstep;
            unsigned v2[2][2];
#pragma unroll
            for (int h_ = 0; h_ < 2; ++h_)
#pragma unroll
                for (int i_ = 0; i_ < 2; ++i_) v2[h_][i_] = last ? vN[h_][i_] : vC[h_][i_];
            if (last && has_next) S.a_ready(nxt);
            PG8_LDB(B0, 0, 0); PG8_LDB(B1, 0, 1); PG8_SCHED; PG8_LDA(At, 0, 0); PG8_STAGE(PG8_SA(1, 1), a1, vC[1]);
            PG8_WAIT_V(8); PG8_WAIT_L(0); PG8_BAR; PG8_MMA(0, 0, At, B0); PG8_MMA(0, 1, At, B1); PG8_BAR; PG8_SCHED;
            PG8_LDA(At, 0, 1); PG8_STAGE(PG8_SB(0, 0), b2, voffB); PG8_STAGE(PG8_SB(0, 1), b2 + hstep, voffB); PG8_STAGE(PG8_SA(0, 0), a2, v2[0]);
            PG8_WAIT_V(8); PG8_WAIT_L(0); PG8_BAR; PG8_MMA(1, 0, At, B0); PG8_MMA(1, 1, At, B1); PG8_BAR; PG8_SCHED;
            PG8_LDB(B0, 1, 0); PG8_LDB(B1, 1, 1); PG8_SCHED; PG8_LDA(At, 1, 0); PG8_STAGE(PG8_SA(0, 1), a2, v2[1]);
            PG8_WAIT_V(8); PG8_WAIT_L(0); PG8_BAR; PG8_MMA(0, 0, At, B0); PG8_MMA(0, 1, At, B1); PG8_BAR; PG8_SCHED;
            PG8_LDA(At, 1, 1); PG8_STAGE(PG8_SB(1, 0), b3, voffB); PG8_STAGE(PG8_SB(1, 1), b3 + hstep, voffB); PG8_STAGE(PG8_SA(1, 0), a3, v2[0]);
            PG8_WAIT_V(8); PG8_WAIT_L(0); PG8_BAR; PG8_MMA(1, 0, At, B0); PG8_MMA(1, 1, At, B1); PG8_BAR; PG8_SCHED;
        }
        if (wr == 0) PG8_BAR;
        if (pend >= 0) S.signal(pend);
        E(acc, cur, wr, wc, fr, fq); S.done(cur); pend = cur.pm;
        if (!has_next) break;
#pragma unroll
        for (int a = 0; a < 2; ++a)
#pragma unroll
            for (int b = 0; b < 2; ++b)
#pragma unroll
                for (int m = 0; m < 4; ++m)
#pragma unroll
                    for (int n = 0; n < 2; ++n) acc[a][b][m][n] = (f32x4){0.f, 0.f, 0.f, 0.f};
        cur = nxt; cB = nB; ++ui;
#pragma unroll
        for (int h_ = 0; h_ < 2; ++h_)
#pragma unroll
            for (int i_ = 0; i_ < 2; ++i_) vC[h_][i_] = vN[h_][i_];
        if (wr == 1) PG8_BAR;
    }
    PG8_WAIT_V(0);
    PG8_BAR;
    if (pend >= 0) S.signal(pend);
#undef PG8_GOFF
#undef PG8_SA
#undef PG8_SB
#undef PG8_STAGE
#undef PG8_LDA
#undef PG8_LDB
#undef PG8_MMA
#undef PG8_WAIT_V
#undef PG8_WAIT_L
#undef PG8_BAR
#undef PG8_SCHED
}
}
constexpr int DM = 1024, NBATCH = 2, SEQ = 16384, NMETA = 16, LQ = SEQ + NMETA, LP = 16640, MP = NBATCH * LP;
constexpr int NBLK16 = LQ / 16;
constexpr int FH = 16, FD = 64;
constexpr int HH = 8, HK = 128, HV = 128;
constexpr int NEXP = 32, EPG = 8, DEXP = 512;
constexpr int XPAD_TILES = 290, XPAD_ROWS = XPAD_TILES * 256;
constexpr float EPS = 1e-6f, LOG2E = 1.4426950408889634f;
constexpr float C2 = 0.125f * LOG2E;
constexpr float SKIP_T = 150.f;

constexpr size_t MiB = 1u << 20;
constexpr size_t WS_CTL = 0, CTL_ZERO_BYTES = 1 * MiB;
constexpr size_t WS_WSM = 1 * MiB;
constexpr size_t WS_WQKV = 2 * MiB, WS_WFO = 8 * MiB, WS_WHI = 10 * MiB, WS_WHO = 18 * MiB, WS_WUP = 20 * MiB, WS_WDN = 148 * MiB;
constexpr size_t WS_H = 212 * MiB;
constexpr size_t WS_XN = 342 * MiB;
constexpr size_t WS_Q = 407 * MiB, WS_K = 472 * MiB, WS_V = 537 * MiB;
constexpr size_t WS_LFT = 602 * MiB, WS_CC = 605 * MiB;
constexpr size_t WS_OG = 608 * MiB;
constexpr size_t WS_TOK = 673 * MiB;
constexpr size_t WS_SROW = WS_TOK + 1280 * 1024;
constexpr size_t WS_RSTD = WS_TOK + 1664 * 1024;
constexpr size_t WS_RS = WS_LFT;
constexpr size_t WS_RB = 675 * MiB;
constexpr size_t WS_XPAD = WS_RB, WS_ACT = WS_RB + 145 * MiB;
constexpr size_t WS_LOGF = WS_RB, WS_SLOC = WS_RB + 130 * MiB, WS_ST = WS_RB + 258 * MiB, WS_BE = WS_RB + 323 * MiB;
constexpr size_t WS_END = 1000 * MiB;
static_assert(WS_XPAD + (size_t)XPAD_ROWS * 2048 <= WS_ACT && WS_ACT + (size_t)XPAD_ROWS * 1024 <= WS_END, "moe map");
static_assert(WS_LOGF + (size_t)MP * 4096 <= WS_SLOC && WS_SLOC + (size_t)2048 * 65536 <= WS_ST && WS_ST + (size_t)2064 * 32768 <= WS_BE && WS_BE + (size_t)2048 * 512 <= WS_END, "hgrn map");
static_assert((size_t)MP * 32 <= 1280 * 1024 && WS_SROW + (size_t)XPAD_ROWS * 4 <= WS_RSTD && WS_RSTD + (size_t)MP * 4 <= WS_RB && (size_t)XPAD_ROWS * 4 <= 2 * MiB, "tok map");
static_assert(WS_H + (size_t)MP * 4096 <= WS_XN && WS_XN + (size_t)MP * 2048 <= WS_Q && WS_V + (size_t)MP * 2048 <= WS_LFT && WS_OG + (size_t)MP * 2048 <= WS_TOK && WS_TOK + (size_t)MP * 32 <= WS_RB, "ws map");
constexpr int CW_BAR = 4096;
constexpr int CW_XMAP = 212992;
constexpr int CW_DEP = 196608;
constexpr int CW_CNT = 131072;
constexpr int RING_BYTES = 131072;
constexpr int MISC_OFF = RING_BYTES;
constexpr int LDS_BYTES = 147456;

#define GAS __attribute__((address_space(1)))
#define LAS __attribute__((address_space(3)))
typedef unsigned short bf16;
typedef unsigned v4u __attribute__((ext_vector_type(4)));
typedef unsigned v2u __attribute__((ext_vector_type(2)));
typedef float f32x4 __attribute__((ext_vector_type(4)));
typedef float f32x16 __attribute__((ext_vector_type(16)));
typedef short bf16x8 __attribute__((ext_vector_type(8)));
typedef short bf16x4 __attribute__((ext_vector_type(4)));
typedef GAS unsigned gu32;
#define RLX_AGENT __ATOMIC_RELAXED, __HIP_MEMORY_SCOPE_AGENT
__device__ __forceinline__ unsigned f2bf(float f) { unsigned u = __builtin_bit_cast(unsigned, f); return (u + 0x7fffu + ((u >> 16) & 1u)) >> 16; }
__device__ __forceinline__ float bf2f(unsigned h) { return __builtin_bit_cast(float, h << 16); }
typedef float f32x2_t __attribute__((ext_vector_type(2))); typedef __bf16 bf16x2_t __attribute__((ext_vector_type(2)));
__device__ __forceinline__ unsigned pk2(float lo, float hi) { f32x2_t v = {lo, hi}; bf16x2_t b = __builtin_convertvector(v, bf16x2_t); return __builtin_bit_cast(unsigned, b); }
__device__ __forceinline__ float bflo(unsigned u) { return __builtin_bit_cast(float, u << 16); }
__device__ __forceinline__ float bfhi(unsigned u) { return __builtin_bit_cast(float, u & 0xffff0000u); }
__device__ __forceinline__ float fexp2(float x) { return __builtin_amdgcn_exp2f(x); }
__device__ __forceinline__ float fexp(float x) { return __builtin_amdgcn_exp2f(x * LOG2E); }
__device__ __forceinline__ float frcp(float x) { return __builtin_amdgcn_rcpf(x); }
__device__ __forceinline__ float silu(float x) { return x * frcp(1.f + fexp(-x)); }
#define XB_TMO      128
#define XB_XCNT(j)  (256  + 64 * (j))
#define XB_XSUB(j)  (1280 + 64 * (j))
#define XB_XGEN(j)  (2304 + 64 * (j))
#define XB_TOP      3328
#define XB_TOPGEN   3392
#define XCD_BAR_WORDS 3456
#define XB_SPIN_CAP (1u << 18)

__device__ __forceinline__ unsigned xb_ld(unsigned* p)              { return __hip_atomic_load(p, __ATOMIC_RELAXED, __HIP_MEMORY_SCOPE_AGENT); }
__device__ __forceinline__ unsigned xb_add(unsigned* p, unsigned v) { return __hip_atomic_fetch_add(p, v, __ATOMIC_RELAXED, __HIP_MEMORY_SCOPE_AGENT); }
__device__ __forceinline__ unsigned xb_xcc_id() { return (unsigned)__builtin_amdgcn_s_getreg((3 << 11) | 20) & 0xFu; }
#define XB_SPIN(cond, bar) do { unsigned _sp = 0; while (cond) { __builtin_amdgcn_s_sleep(1); \
    if ((++_sp & 255u) == 0u) { if (xb_ld(&(bar)[XB_TMO])) break; if (_sp > XB_SPIN_CAP) { atomicAdd(&(bar)[XB_TMO], 1u); break; } } } } while (0)

struct XcdBarrier {
    unsigned* bar; unsigned x;
    volatile LAS unsigned* st;
};

__device__ __forceinline__ XcdBarrier xcd_barrier_post(unsigned* bar, volatile LAS unsigned* st) {
    XcdBarrier b; b.bar = bar; b.x = xb_xcc_id(); b.st = st;
    if (threadIdx.x == 0) (void)xb_add(&bar[XB_XCNT(b.x)], 1u);
    return b;
}
__device__ __forceinline__ void xcd_barrier_complete(unsigned* bar, unsigned x, unsigned& nloc, unsigned& nx) {
    const unsigned G = gridDim.x * gridDim.y * gridDim.z;
    unsigned sum, cnt, mine, sp = 0u;
    for (;;) {
        sum = 0u; cnt = 0u; mine = 0u;
#pragma unroll
        for (unsigned j = 0; j < 16; ++j) { const unsigned c = xb_ld(&bar[XB_XCNT(j)]); sum += c; cnt += (c > 0u) ? 1u : 0u; mine = (j == x) ? c : mine; }
        if (sum == G) break;
        __builtin_amdgcn_s_sleep(1);
        if ((++sp & 255u) == 0u) { if (xb_ld(&bar[XB_TMO])) break; if (sp > XB_SPIN_CAP) { atomicAdd(&bar[XB_TMO], 1u); break; } }
    }
    nloc = mine > 0u ? mine : 1u; nx = cnt > 0u ? cnt : 1u;
}

__device__ __forceinline__ void xcd_barrier(const XcdBarrier& b) {
    asm volatile("s_waitcnt vmcnt(0)" ::: "memory");
    __syncthreads();
    if (threadIdx.x == 0) {
        unsigned* bar = b.bar;
        __builtin_amdgcn_s_waitcnt(0);
        unsigned nloc = b.st[0], nx = b.st[1];
        if (nloc == 0u) { xcd_barrier_complete(bar, b.x, nloc, nx); b.st[0] = nloc; b.st[1] = nx; }
        const unsigned old = xb_add(&bar[XB_XSUB(b.x)], 1u);
        const unsigned gen = old / nloc;
        if (old + 1u == (gen + 1u) * nloc) {
            __builtin_amdgcn_fence(__ATOMIC_RELEASE, "agent");
            asm volatile("s_waitcnt vmcnt(0)" ::: "memory");
            const unsigned og = xb_add(&bar[XB_TOP], 1u);
            const unsigned tg = og / nx;
            if (og + 1u == (tg + 1u) * nx) xb_add(&bar[XB_TOPGEN], 1u);
            else XB_SPIN(xb_ld(&bar[XB_TOPGEN]) == tg, bar);
            __builtin_amdgcn_fence(__ATOMIC_ACQUIRE, "agent");
            xb_add(&bar[XB_XGEN(b.x)], 1u);
            asm volatile("s_waitcnt vmcnt(0)" ::: "memory");
        } else {
            XB_SPIN(xb_ld(&bar[XB_XGEN(b.x)]) == gen, bar);
            __builtin_amdgcn_fence(__ATOMIC_ACQUIRE, "agent");
            asm volatile("s_waitcnt vmcnt(0)" ::: "memory");
        }
    }
    __syncthreads();
}
struct Frame {
    LAS unsigned char* lds;
    unsigned char* ws;
    unsigned* ctl;
    int tid, lane, wave, vcu, G;
    const float* in[21]; float* out;
};
enum { I_X = 0, I_META, I_FOX_NORM, I_FOX_WIN, I_FOX_BF, I_FOX_QN, I_FOX_KN, I_FOX_WOUT, I_HG_NORM, I_HG_WIN, I_HG_BF, I_HG_LB, I_HG_ON, I_HG_WOUT,
       I_MOE_NORM, I_MOE_WGRP, I_MOE_BGRP, I_MOE_WRT, I_MOE_BRT, I_MOE_WUP, I_MOE_WDN };

__device__ __forceinline__ float wave_sum(float v) {
#pragma unroll
    for (int o = 1; o < 64; o <<= 1) v += __shfl_xor(v, o);
    return v;
}

struct TrItem { const float* W; bf16* WT; int ldn, K, k0, n0, orow0; const float* gain; };
__device__ __forceinline__ void tr_load(const TrItem& I, int lane, float (&v)[32]) {
#pragma unroll
    for (int i = 0; i < 32; ++i) { const int kk = 2 * i + (lane >> 5); v[i] = I.W[(size_t)(I.k0 + kk) * I.ldn + I.n0 + (lane & 31)] * (I.gain ? I.gain[I.k0 + kk] : 1.f); }
}
__device__ __forceinline__ void tr_store(const TrItem& I, int lane, const float (&v)[32], LAS float* scr) {
#pragma unroll
    for (int i = 0; i < 32; ++i) { const int kk = 2 * i + (lane >> 5); scr[kk * 33 + (lane & 31)] = v[i]; }
    asm volatile("s_waitcnt lgkmcnt(0)" ::: "memory");
    const int c = lane & 7;
#pragma unroll
    for (int j = 0; j < 4; ++j) { const int n = (lane >> 3) + 8 * j; const LAS float* s = scr + (8 * c) * 33 + n;
        v4u o; o.x = pk2(s[0 * 33], s[1 * 33]); o.y = pk2(s[2 * 33], s[3 * 33]); o.z = pk2(s[4 * 33], s[5 * 33]); o.w = pk2(s[6 * 33], s[7 * 33]);
        *(v4u*)(I.WT + (size_t)(I.orow0 + n) * I.K + I.k0 + 8 * c) = o; }
    asm volatile("s_waitcnt lgkmcnt(0)" ::: "memory");
}
__device__ __forceinline__ int perm_qkv(int n0) { const int tile = n0 >> 8, r = n0 & 255, wc = r >> 6, bj = (r >> 5) & 1; return (tile << 8) + 128 * bj + 32 * wc; }
__device__ __forceinline__ int perm_up(int n0) { const int bj = n0 >> 9, rem = n0 & 511, pn = rem >> 7, j = rem & 127; return 256 * pn + 128 * bj + j; }

__device__ __forceinline__ TrItem moe_item(const Frame& F, int r) {
    constexpr int I_UP1 = 16 * 32, I_UP = 64 * I_UP1, I_DN1 = 8 * 32;
    bf16* WUP = (bf16*)(F.ws + WS_WUP); bf16* WDN = (bf16*)(F.ws + WS_WDN);
    if (r < I_UP) { const int e = r / I_UP1, q = r % I_UP1, kb = q / 32, nb = q % 32;
        return TrItem{F.in[I_MOE_WUP] + (size_t)e * DM * DM, WUP + (size_t)e * DM * DM, DM, DM, 64 * kb, 32 * nb, perm_up(32 * nb), F.in[I_MOE_NORM] + (e >> 5) * DM}; }
    r -= I_UP; const int e = r / I_DN1, q = r % I_DN1, kb = q / 32, nb = q % 32;
    return TrItem{F.in[I_MOE_WDN] + (size_t)e * DEXP * DM, WDN + (size_t)e * DM * DEXP, DM, DEXP, 64 * kb, 32 * nb, 32 * nb, nullptr};
}
__device__ __forceinline__ TrItem dense_item(const Frame& F, int r) {
    constexpr int I_QKV = 16 * 96, I_FO = 16 * 32, I_HI = 16 * 128;
    if (r < I_QKV) { const int kb = r / 96, nb = r % 96; return TrItem{F.in[I_FOX_WIN], (bf16*)(F.ws + WS_WQKV), 3 * DM + FH, DM, 64 * kb, 32 * nb, perm_qkv(32 * nb), F.in[I_FOX_NORM]}; } r -= I_QKV;
    if (r < I_FO) { const int kb = r / 32, nb = r % 32; return TrItem{F.in[I_FOX_WOUT], (bf16*)(F.ws + WS_WFO), DM, DM, 64 * kb, 32 * nb, 32 * nb, nullptr}; } r -= I_FO;
    if (r < I_HI) { const int kb = r / 128, nb = r % 128; return TrItem{F.in[I_HG_WIN], (bf16*)(F.ws + WS_WHI), 4 * DM, DM, 64 * kb, 32 * nb, 32 * nb, F.in[I_HG_NORM]}; } r -= I_HI;
    { const int kb = r / 32, nb = r % 32; return TrItem{F.in[I_HG_WOUT], (bf16*)(F.ws + WS_WHO), DM, DM, 64 * kb, 32 * nb, 32 * nb, nullptr}; }
}
#define TR_PIPELINE(ITEM_FN, NITEMS_) do { LAS float* scr = (LAS float*)(F.lds + F.wave * 16384); const int NGW = F.G * 8; int it = F.vcu * 8 + F.wave; \
    if (it < (NITEMS_)) { TrItem cur = ITEM_FN(F, it); float va[32], vb[32]; tr_load(cur, F.lane, va); \
        for (;;) { { const int itn = it + NGW; TrItem nx = cur; __builtin_amdgcn_s_waitcnt(0x0F70); if (itn < (NITEMS_)) { nx = ITEM_FN(F, itn); tr_load(nx, F.lane, vb); } tr_store(cur, F.lane, va, scr); it = itn; cur = nx; if (it >= (NITEMS_)) break; } \
                   { const int itn = it + NGW; TrItem nx = cur; __builtin_amdgcn_s_waitcnt(0x0F70); if (itn < (NITEMS_)) { nx = ITEM_FN(F, itn); tr_load(nx, F.lane, va); } tr_store(cur, F.lane, vb, scr); it = itn; cur = nx; if (it >= (NITEMS_)) break; } } } } while (0)
__device__ __forceinline__ void p0_moe_weights(const Frame& F) { TR_PIPELINE(moe_item, 64 * 16 * 32 + 64 * 8 * 32); }
__device__ __forceinline__ void p0_prologue(const Frame& F) {
    TR_PIPELINE(dense_item, 16 * 96 + 16 * 32 + 16 * 128 + 16 * 32);
    const int gt = F.vcu * 512 + F.tid, NGT = F.G * 512;
    bf16* WSM = (bf16*)(F.ws + WS_WSM);
    for (int i = gt; i < 16 * 1024 + 2 * 48 * 1024; i += NGT) {
        float w; bf16* hi; bf16* lo;
        if (i < 16 * 1024) { const int n = i >> 10, k = i & 1023; w = F.in[I_FOX_WIN][(size_t)k * (3 * DM + FH) + 3 * DM + n]; hi = WSM + i; lo = WSM + 16384 + i; }
        else { const int j = i - 16 * 1024, l = j / (48 * 1024), q = j % (48 * 1024), n = q >> 10, k = q & 1023;
            w = n < 4 ? F.in[I_MOE_WGRP][((size_t)l * DM + k) * 4 + n] : (n < 36 ? F.in[I_MOE_WRT][((size_t)l * DM + k) * 32 + (n - 4)] : 0.f);
            hi = WSM + 32768 + (size_t)l * 98304 + q; lo = hi + 49152; }
        const unsigned h = f2bf(w); *hi = (bf16)h; *lo = (bf16)f2bf(w - bf2f(h));
    }
    for (int i = gt; i < 4 * NBATCH * (LP - LQ) * 128; i += NGT) { const int which = i / (NBATCH * (LP - LQ) * 128), j = i % (NBATCH * (LP - LQ) * 128), b = j / ((LP - LQ) * 128), q = j % ((LP - LQ) * 128);
        v4u* base = (v4u*)(F.ws + (which == 0 ? WS_H : which == 1 ? WS_Q : which == 2 ? WS_K : WS_V));
        base[((size_t)b * LP + LQ) * 128 + q] = (v4u){0u, 0u, 0u, 0u}; }
}

__device__ __forceinline__ void lds_row8g(const LAS float* p, float (&v)[8]) { const f32x4 a = *(const LAS f32x4*)p, c = *(const LAS f32x4*)(p + 4);
    v[0] = a.x; v[1] = a.y; v[2] = a.z; v[3] = a.w; v[4] = c.x; v[5] = c.y; v[6] = c.z; v[7] = c.w; }
template <int MODE> struct TRegs { f32x4 a[4], c[4]; v4u h[4]; v4u u1[4], u2[4]; float w1, w2; };
template <int MODE> struct TTok { v4u ta; v2u tb; };
template <int MODE> __device__ __forceinline__ void t_tok(const Frame& F, int it, TTok<MODE>& T) {
    if (MODE == 2) { const int r = F.lane & 15, b = it / NBLK16, t = (it % NBLK16) * 16 + r; const unsigned* TOK = (const unsigned*)(F.ws + WS_TOK) + ((size_t)b * LP + t) * 8;
        T.ta = *(const v4u*)TOK; T.tb = *(const v2u*)(TOK + 4); }
}
template <int MODE> __device__ __forceinline__ void t_load(const Frame& F, int it, const TTok<MODE>& T, TRegs<MODE>& R) {
    const int r = F.lane & 15, g = F.lane >> 4, w = F.wave, b = it / NBLK16, t = (it % NBLK16) * 16 + r; const size_t row = (size_t)b * LP + t;
    const bf16* H = (const bf16*)(F.ws + WS_H); const bf16* Y = (const bf16*)(F.ws + WS_XPAD);
    const float* src = (t < NMETA ? F.in[I_META] + (size_t)t * DM : F.in[I_X] + ((size_t)b * SEQ + (t - NMETA)) * DM);
    const bf16* y1 = nullptr; const bf16* y2 = nullptr;
    if (MODE == 2) { const unsigned wa = T.ta.y, wb = T.ta.z; R.w1 = __uint_as_float(wa); R.w2 = __uint_as_float(wb); y1 = Y + (size_t)T.tb.x * DM; y2 = Y + (size_t)T.tb.y * DM; }
#pragma unroll
    for (int ks = 0; ks < 4; ++ks) { const int k0 = 128 * w + 32 * ks + 8 * g;
        if (MODE == 0) { R.a[ks] = *(const f32x4*)(src + k0); R.c[ks] = *(const f32x4*)(src + k0 + 4); } else R.h[ks] = *(const v4u*)(H + row * DM + k0);
        if (MODE == 2) { R.u1[ks] = *(const v4u*)(y1 + k0); R.u2[ks] = *(const v4u*)(y2 + k0); } }
}
template <int MODE, int NB, int POST, bool FINAL>
__device__ __forceinline__ void t_proc(const Frame& F, int it, int par, TRegs<MODE>& R, const bf16x8 (&wh)[NB > 0 ? NB : 1][4], const bf16x8 (&wl)[NB > 0 ? NB : 1][4], int layer) {
    const LAS float* gnl = (const LAS float*)(F.lds + 57344);
    const LAS float* bia = (const LAS float*)(F.lds + 61440);
    LAS float* ssq = (LAS float*)(F.lds);
    LAS float* lg = (LAS float*)(F.lds + 1024);
    LAS float* lgs = (LAS float*)(F.lds + 1024 + 49152);
    const int r = F.lane & 15, g = F.lane >> 4, w = F.wave;
    bf16* H = (bf16*)(F.ws + WS_H); unsigned* TOK = (unsigned*)(F.ws + WS_TOK);
    const int b = it / NBLK16, t0 = (it % NBLK16) * 16, t = t0 + r; const size_t row = (size_t)b * LP + t;
    float val[4][8]; float ss = 0.f;
#pragma unroll
    for (int ks = 0; ks < 4; ++ks) {
        const int k0 = 128 * w + 32 * ks + 8 * g;
        f32x4 a, c;
        if (MODE == 0) { a = R.a[ks]; c = R.c[ks]; } else { const v4u hh = R.h[ks]; a = (f32x4){bflo(hh.x), bfhi(hh.x), bflo(hh.y), bfhi(hh.y)}; c = (f32x4){bflo(hh.z), bfhi(hh.z), bflo(hh.w), bfhi(hh.w)}; }
        if (MODE == 2) { const v4u u1 = R.u1[ks], u2 = R.u2[ks]; const float w1 = R.w1, w2 = R.w2;
            a.x += w1 * bflo(u1.x) + w2 * bflo(u2.x); a.y += w1 * bfhi(u1.x) + w2 * bfhi(u2.x); a.z += w1 * bflo(u1.y) + w2 * bflo(u2.y); a.w += w1 * bfhi(u1.y) + w2 * bfhi(u2.y);
            c.x += w1 * bflo(u1.z) + w2 * bflo(u2.z); c.y += w1 * bfhi(u1.z) + w2 * bfhi(u2.z); c.z += w1 * bflo(u1.w) + w2 * bflo(u2.w); c.w += w1 * bfhi(u1.w) + w2 * bfhi(u2.w); }
        if (FINAL) { if (t >= NMETA) { float* o = F.out + ((size_t)b * SEQ + (t - NMETA)) * DM + k0; *(f32x4*)o = a; *(f32x4*)(o + 4) = c; } }
        else if (MODE != 1) { v4u hv; hv.x = pk2(a.x, a.y); hv.y = pk2(a.z, a.w); hv.z = pk2(c.x, c.y); hv.w = pk2(c.z, c.w); *(v4u*)(H + row * DM + k0) = hv;
            a = (f32x4){bflo(hv.x), bfhi(hv.x), bflo(hv.y), bfhi(hv.y)}; c = (f32x4){bflo(hv.z), bfhi(hv.z), bflo(hv.w), bfhi(hv.w)}; }
        val[ks][0] = a.x; val[ks][1] = a.y; val[ks][2] = a.z; val[ks][3] = a.w; val[ks][4] = c.x; val[ks][5] = c.y; val[ks][6] = c.z; val[ks][7] = c.w;
        ss += (a.x * a.x + a.y * a.y) + (a.z * a.z + a.w * a.w) + (c.x * c.x + c.y * c.y) + (c.z * c.z + c.w * c.w);
    }
    if (FINAL) return;
    if (NB > 0) {
        f32x4 acc[NB > 0 ? NB : 1];
#pragma unroll
        for (int nb = 0; nb < NB; ++nb) acc[nb] = (f32x4){0.f, 0.f, 0.f, 0.f};
#pragma unroll
        for (int ks = 0; ks < 4; ++ks) {
            float gk[8]; lds_row8g(gnl + 128 * w + 32 * ks + 8 * g, gk);
            v4u hp, lp;
#pragma unroll
            for (int j = 0; j < 4; ++j) { const float x0 = val[ks][2 * j] * gk[2 * j], x1 = val[ks][2 * j + 1] * gk[2 * j + 1]; const unsigned h = pk2(x0, x1);
                hp[j] = h; lp[j] = pk2(x0 - bflo(h), x1 - bfhi(h)); }
            const bf16x8 ah = __builtin_bit_cast(bf16x8, hp), al = __builtin_bit_cast(bf16x8, lp);
#pragma unroll
            for (int nb = 0; nb < NB; ++nb) {
                const bf16x8 bh = wh[nb][ks], bl = wl[nb][ks];
                acc[nb] = __builtin_amdgcn_mfma_f32_16x16x32_bf16(ah, bh, acc[nb], 0, 0, 0);
                acc[nb] = __builtin_amdgcn_mfma_f32_16x16x32_bf16(ah, bl, acc[nb], 0, 0, 0);
                acc[nb] = __builtin_amdgcn_mfma_f32_16x16x32_bf16(al, bh, acc[nb], 0, 0, 0);
            }
        }
#pragma unroll
        for (int nb = 0; nb < NB; ++nb)
#pragma unroll
            for (int q = 0; q < 4; ++q) lg[((par * 8 + w) * 16 + 4 * g + q) * 48 + 16 * nb + r] = acc[nb][q];
    }
    ss += __shfl_xor(ss, 16); ss += __shfl_xor(ss, 32);
    if (g == 0) ssq[par * 128 + w * 16 + r] = ss;
    __syncthreads();
    float tot = 0.f;
#pragma unroll
    for (int ww = 0; ww < 8; ++ww) tot += ssq[par * 128 + ww * 16 + r];
    const float rstd = __builtin_amdgcn_rsqf(tot * (1.f / DM) + EPS);
    if (w == 0 && g == 0) ((float*)(F.ws + WS_RSTD))[row] = rstd;
    if (POST == 1) {
        if (F.tid < 256) { const int rr = F.tid >> 4, n = F.tid & 15; float s = 0.f, tt = 0.f;
#pragma unroll
            for (int ww = 0; ww < 8; ++ww) { s += lg[((par * 8 + ww) * 16 + rr) * 48 + n]; tt += ssq[par * 128 + ww * 16 + rr]; }
            const float x = s * __builtin_amdgcn_rsqf(tt * (1.f / DM) + EPS) + bia[n];
            const float lf = (x >= 0.f) ? -log1pf(__expf(-x)) : x - log1pf(__expf(x));
            ((float*)(F.ws + WS_LFT))[(size_t)(b * FH + n) * LP + t0 + rr] = lf * LOG2E; }
    }
    if (POST == 2) {
        if (w == 0) {
#pragma unroll
            for (int q = 0; q < 12; ++q) { const int idx = F.lane + 64 * q, rr = idx / 48, n = idx % 48; float s = 0.f;
#pragma unroll
                for (int ww = 0; ww < 8; ++ww) s += lg[((par * 8 + ww) * 16 + rr) * 48 + n];
                lgs[par * 768 + idx] = s; }
            asm volatile("s_waitcnt lgkmcnt(0)" ::: "memory");
            __builtin_amdgcn_wave_barrier();
            if (F.lane < 16) {
                const LAS float* L = lgs + par * 768 + r * 48;
                const LAS float* bg = bia; const LAS float* br = bia + 4;
                float gl[4]; int gi = 0; float gm;
#pragma unroll
                for (int j = 0; j < 4; ++j) gl[j] = L[j] * rstd + bg[j];
                gm = gl[0];
#pragma unroll
                for (int j = 1; j < 4; ++j) if (gl[j] > gm) { gm = gl[j]; gi = j; }
                float gsum = 0.f;
#pragma unroll
                for (int j = 0; j < 4; ++j) gsum += __expf(gl[j] - gm);
                const float ggate = 1.f / gsum;
                float v1 = -3.0e38f, v2 = -3.0e38f; int i1 = 0, i2 = 0;
#pragma unroll
                for (int j = 0; j < 8; ++j) { const float e = L[4 + 8 * gi + j] * rstd + br[8 * gi + j];
                    if (e > v1) { v2 = v1; i2 = i1; v1 = e; i1 = j; } else if (e > v2) { v2 = e; i2 = j; } }
                const float ex = __expf(v2 - v1), p1 = 1.f / (1.f + ex);
                const int e1 = 8 * gi + i1, e2 = 8 * gi + i2;
                v4u ta; ta.x = (unsigned)e1 | ((unsigned)e2 << 8); ta.y = __builtin_bit_cast(unsigned, ggate * p1); ta.z = __builtin_bit_cast(unsigned, ggate * ex * p1); ta.w = __builtin_bit_cast(unsigned, rstd);
                *(v4u*)(TOK + row * 8) = ta;
                LAS unsigned* hist = (LAS unsigned*)(F.lds + 61440 + 256);
                __hip_atomic_fetch_add(hist + e1, 1u, __ATOMIC_RELAXED, __HIP_MEMORY_SCOPE_WORKGROUP);
                __hip_atomic_fetch_add(hist + e2, 1u, __ATOMIC_RELAXED, __HIP_MEMORY_SCOPE_WORKGROUP);
            }
        }
    }
}
template <int MODE, int NB, int POST, bool FINAL>
__device__ __forceinline__ void t_phase(const Frame& F, const float* __restrict__ gain, const bf16* __restrict__ wsm_hi, const bf16* __restrict__ wsm_lo, int layer) {
    constexpr int NIT = NBATCH * NBLK16;
    const int r = F.lane & 15, g = F.lane >> 4, w = F.wave;
    bf16x8 wh[NB > 0 ? NB : 1][4], wl[NB > 0 ? NB : 1][4];
    if (POST == 2) { int* SROW = (int*)(F.ws + WS_SROW); for (int i = F.vcu * 512 + F.tid; i < XPAD_ROWS; i += F.G * 512) SROW[i] = 0; }
    if (!FINAL) {
        LAS float* gnl = (LAS float*)(F.lds + 57344); LAS float* bia = (LAS float*)(F.lds + 61440);
        { const float g0 = gain[F.tid], g1 = gain[F.tid + 512]; gnl[F.tid] = g0; gnl[F.tid + 512] = g1; }
        if (POST == 1 && F.tid < 16) bia[F.tid] = F.in[I_FOX_BF][F.tid];
        if (POST == 2 && F.tid < 36) bia[F.tid] = F.tid < 4 ? F.in[I_MOE_BGRP][layer * 4 + F.tid] : F.in[I_MOE_BRT][layer * 32 + F.tid - 4];
        if (POST == 2 && F.tid < NEXP) ((LAS unsigned*)(F.lds + 61440 + 256))[F.tid] = 0u;
#pragma unroll
        for (int nb = 0; nb < NB; ++nb)
#pragma unroll
            for (int ks = 0; ks < 4; ++ks) { const int k0 = 128 * w + 32 * ks + 8 * g;
                wh[nb][ks] = *(const bf16x8*)(wsm_hi + (size_t)(16 * nb + r) * DM + k0); wl[nb][ks] = *(const bf16x8*)(wsm_lo + (size_t)(16 * nb + r) * DM + k0); }
        __syncthreads();
    }
    int it = blockIdx.x;
    if (it < NIT) {
        TRegs<MODE> A, B; TTok<MODE> T0, T1;
        t_tok<MODE>(F, it, T0); if (it + F.G < NIT) t_tok<MODE>(F, it + F.G, T1);
        t_load<MODE>(F, it, T0, A);
        int par = 0;
        for (;;) {
            { const int itn = it + F.G; __builtin_amdgcn_s_waitcnt(0x0F70); if (itn < NIT) { t_load<MODE>(F, itn, T1, B); if (itn + F.G < NIT) t_tok<MODE>(F, itn + F.G, T0); }
              t_proc<MODE, NB, POST, FINAL>(F, it, par, A, wh, wl, layer); par ^= 1; it = itn; if (it >= NIT) break; }
            { const int itn = it + F.G; __builtin_amdgcn_s_waitcnt(0x0F70); if (itn < NIT) { t_load<MODE>(F, itn, T0, A); if (itn + F.G < NIT) t_tok<MODE>(F, itn + F.G, T1); }
              t_proc<MODE, NB, POST, FINAL>(F, it, par, B, wh, wl, layer); par ^= 1; it = itn; if (it >= NIT) break; }
        }
    }
    __syncthreads();
    if (POST == 2 && F.tid < NEXP) { const unsigned hv = ((LAS unsigned*)(F.lds + 61440 + 256))[F.tid]; if (hv) __hip_atomic_fetch_add(F.ctl + CW_CNT + layer * 2048 + F.tid * 16, hv, RLX_AGENT); }
}
struct EpiQKV {
    static constexpr bool PERM = true, AFTER_DRAIN = false;
    bf16* Q; const float* gq; const float* gk; const LAS float* rstd;
    __device__ __forceinline__ void operator()(const pg8::f32x4 (&acc)[2][2][4][2], const pg8::Unit& u, int wr, int wc, int fr, int fq) const {
        const int type = u.pn >> 2, head = (u.pn & 3) * 4 + wc;
        bf16* dst = Q + (size_t)type * ((WS_K - WS_Q) / 2);
        float gs[2][8];
        if (type < 2) {
#pragma unroll
            for (int bj = 0; bj < 2; ++bj)
#pragma unroll
                for (int j = 0; j < 8; ++j) { const float a = gq[32 * bj + 8 * fq + j] * C2, b = gk[32 * bj + 8 * fq + j]; gs[bj][j] = type == 0 ? a : b; } }
        const int row0 = u.pm * 256 + wr * 64 + fr;
#pragma unroll
        for (int ai = 0; ai < 2; ++ai)
#pragma unroll
            for (int m = 0; m < 4; ++m) {
                const size_t row = (size_t)(row0 + ai * 128 + m * 16);
                float sc = rstd[u.ord * 256 + wr * 64 + fr + ai * 128 + m * 16];
                if (type < 2) { float ss = 0.f;
#pragma unroll
                    for (int bj = 0; bj < 2; ++bj)
#pragma unroll
                        for (int n = 0; n < 2; ++n) { const pg8::f32x4 x = acc[ai][bj][m][n]; ss += (x[0] * x[0] + x[1] * x[1]) + (x[2] * x[2] + x[3] * x[3]); }
                    ss += __shfl_xor(ss, 16); ss += __shfl_xor(ss, 32);
                    sc = sc * __builtin_amdgcn_rsqf(sc * sc * ss * (1.f / FD) + EPS); }
#pragma unroll
                for (int bj = 0; bj < 2; ++bj) {
                    pg8::f32x4 v0 = acc[ai][bj][m][0], v1 = acc[ai][bj][m][1];
                    if (type < 2) { v0[0] *= sc * gs[bj][0]; v0[1] *= sc * gs[bj][1]; v0[2] *= sc * gs[bj][2]; v0[3] *= sc * gs[bj][3];
                                    v1[0] *= sc * gs[bj][4]; v1[1] *= sc * gs[bj][5]; v1[2] *= sc * gs[bj][6]; v1[3] *= sc * gs[bj][7]; }
                    else { v0 *= sc; v1 *= sc; }
                    v4u o; o.x = pk2(v0[0], v0[1]); o.y = pk2(v0[2], v0[3]); o.z = pk2(v1[0], v1[1]); o.w = pk2(v1[2], v1[3]);
                    *(v4u*)(dst + row * DM + head * FD + 32 * bj + 8 * fq) = o;
                }
            }
    }
};
struct EpiResid {
    static constexpr bool PERM = true, AFTER_DRAIN = false;
    bf16* H;
    __device__ __forceinline__ void operator()(const pg8::f32x4 (&acc)[2][2][4][2], const pg8::Unit& u, int wr, int wc, int fr, int fq) const {
        const int row0 = u.pm * 256 + wr * 64 + fr, col0 = u.pn * 256 + 32 * wc + 8 * fq;
#pragma unroll
        for (int ai = 0; ai < 2; ++ai)
#pragma unroll
            for (int m = 0; m < 4; ++m)
#pragma unroll
                for (int bj = 0; bj < 2; ++bj) { bf16* p = H + (size_t)(row0 + ai * 128 + m * 16) * DM + col0 + 128 * bj;
                    const v4u hh = *(const v4u*)p; const pg8::f32x4 x0 = acc[ai][bj][m][0], x1 = acc[ai][bj][m][1];
                    v4u o; o.x = pk2(bflo(hh.x) + x0[0], bfhi(hh.x) + x0[1]); o.y = pk2(bflo(hh.y) + x0[2], bfhi(hh.y) + x0[3]);
                    o.z = pk2(bflo(hh.z) + x1[0], bfhi(hh.z) + x1[1]); o.w = pk2(bflo(hh.w) + x1[2], bfhi(hh.w) + x1[3]);
                    *(v4u*)p = o; }
    }
};
struct EpiResidX {
    static constexpr bool PERM = true, AFTER_DRAIN = false;
    bf16* H; const float* x; const float* meta;
    __device__ __forceinline__ void operator()(const pg8::f32x4 (&acc)[2][2][4][2], const pg8::Unit& u, int wr, int wc, int fr, int fq) const {
        const int row0 = u.pm * 256 + wr * 64 + fr, col0 = u.pn * 256 + 32 * wc + 8 * fq;
#pragma unroll
        for (int ai = 0; ai < 2; ++ai)
#pragma unroll
            for (int m = 0; m < 4; ++m) { const int row = row0 + ai * 128 + m * 16, b = row / LP, t = row - b * LP;
                if (t < LQ) { const float* src = (t < NMETA ? meta + (size_t)t * DM : x + ((size_t)b * SEQ + (t - NMETA)) * DM) + col0;
#pragma unroll
                    for (int bj = 0; bj < 2; ++bj) { bf16* p = H + (size_t)row * DM + col0 + 128 * bj;
                        f32x4 a = *(const f32x4*)(src + 128 * bj), c = *(const f32x4*)(src + 128 * bj + 4);
                        a += acc[ai][bj][m][0]; c += acc[ai][bj][m][1];
                        v4u o; o.x = pk2(a.x, a.y); o.y = pk2(a.z, a.w); o.z = pk2(c.x, c.y); o.w = pk2(c.z, c.w);
                        *(v4u*)p = o; } } }
    }
};
struct EpiUp {
    static constexpr bool PERM = true, AFTER_DRAIN = false;
    bf16* ACT; const LAS float* rs;
    __device__ __forceinline__ void operator()(const pg8::f32x4 (&acc)[2][2][4][2], const pg8::Unit& u, int wr, int wc, int fr, int fq) const {
        const int row0 = u.pm * 256 + wr * 64 + fr, col0 = (u.pn & 3) * 128 + 32 * wc + 8 * fq;
#pragma unroll
        for (int ai = 0; ai < 2; ++ai)
#pragma unroll
            for (int m = 0; m < 4; ++m) {
                const float sc = rs[u.ord * 256 + wr * 64 + fr + ai * 128 + m * 16];
                const pg8::f32x4 a0 = acc[ai][0][m][0] * sc, a1 = acc[ai][0][m][1] * sc, u0 = acc[ai][1][m][0] * sc, u1 = acc[ai][1][m][1] * sc;
                v4u o; o.x = pk2(silu(a0[0]) * u0[0], silu(a0[1]) * u0[1]); o.y = pk2(silu(a0[2]) * u0[2], silu(a0[3]) * u0[3]);
                o.z = pk2(silu(a1[0]) * u1[0], silu(a1[1]) * u1[1]); o.w = pk2(silu(a1[2]) * u1[2], silu(a1[3]) * u1[3]);
                *(v4u*)(ACT + (size_t)(row0 + ai * 128 + m * 16) * DEXP + col0) = o;
            }
    }
};
struct EpiDown {
    static constexpr bool PERM = true, AFTER_DRAIN = false;
    bf16* Y;
    __device__ __forceinline__ void operator()(const pg8::f32x4 (&acc)[2][2][4][2], const pg8::Unit& u, int wr, int wc, int fr, int fq) const {
        const int row0 = u.pm * 256 + wr * 64 + fr, col0 = (u.pn & 3) * 256 + 32 * wc + 8 * fq;
#pragma unroll
        for (int ai = 0; ai < 2; ++ai)
#pragma unroll
            for (int m = 0; m < 4; ++m)
#pragma unroll
                for (int bj = 0; bj < 2; ++bj) { const pg8::f32x4 v0 = acc[ai][bj][m][0], v1 = acc[ai][bj][m][1];
                    v4u o; o.x = pk2(v0[0], v0[1]); o.y = pk2(v0[2], v0[3]); o.z = pk2(v1[0], v1[1]); o.w = pk2(v1[2], v1[3]);
                    *(v4u*)(Y + (size_t)(row0 + ai * 128 + m * 16) * DM + col0 + 128 * bj) = o; }
    }
};
struct EpiHgIn {
    static constexpr bool PERM = true, AFTER_DRAIN = false;
    bf16* QS; float* LOGF; const float* bfv; const float* lbl; const LAS float* rstd;
    __device__ __forceinline__ void operator()(const pg8::f32x4 (&acc)[2][2][4][2], const pg8::Unit& u, int wr, int wc, int fr, int fq) const {
        const int type = u.pn >> 2, row0 = u.pm * 256 + wr * 64 + fr, col0 = (u.pn & 3) * 256 + 32 * wc + 8 * fq;
        float bias[2][8], lb[2][8];
        if (type == 1) {
#pragma unroll
            for (int bj = 0; bj < 2; ++bj)
#pragma unroll
                for (int j = 0; j < 8; ++j) { const int c = col0 + 128 * bj + j; bias[bj][j] = bfv[c]; lb[bj][j] = frcp(1.f + fexp(lbl[c] - lbl[DM + c])); }
        }
        bf16* dst = QS + (size_t)(type == 0 ? 0 : (type == 2 ? 2 : 1)) * ((WS_K - WS_Q) / 2);
#pragma unroll
        for (int ai = 0; ai < 2; ++ai)
#pragma unroll
            for (int m = 0; m < 4; ++m)
#pragma unroll
                for (int bj = 0; bj < 2; ++bj) {
                    const size_t off = (size_t)(row0 + ai * 128 + m * 16) * DM + col0 + 128 * bj;
                    float v[8]; const float sc = rstd[u.ord * 256 + wr * 64 + fr + ai * 128 + m * 16];
#pragma unroll
                    for (int j = 0; j < 4; ++j) { v[j] = acc[ai][bj][m][0][j] * sc; v[4 + j] = acc[ai][bj][m][1][j] * sc; }
                    if (type == 1) {
#pragma unroll
                        for (int j = 0; j < 8; ++j) { const float sg = frcp(1.f + fexp(-(v[j] + bias[bj][j]))); const float f = lb[bj][j] + (1.f - lb[bj][j]) * sg; v[j] = __logf(f); }
                        *(f32x4*)(LOGF + off) = (f32x4){v[0], v[1], v[2], v[3]}; *(f32x4*)(LOGF + off + 4) = (f32x4){v[4], v[5], v[6], v[7]};
                    } else {
                        if (type != 2) {
#pragma unroll
                            for (int j = 0; j < 8; ++j) v[j] = silu(v[j]); }
                        v4u o; o.x = pk2(v[0], v[1]); o.y = pk2(v[2], v[3]); o.z = pk2(v[4], v[5]); o.w = pk2(v[6], v[7]);
                        *(v4u*)(dst + off) = o;
                    }
                }
    }
};

__device__ __forceinline__ void fox_scan(const Frame& F) {
    if (blockIdx.x >= NBATCH * FH) return;
    LAS float* buf = (LAS float*)F.lds;
    LAS float* wt = (LAS float*)(F.lds + 69632);
    const float* src = (const float*)(F.ws + WS_LFT) + (size_t)blockIdx.x * LP; float* dst = (float*)(F.ws + WS_CC) + (size_t)blockIdx.x * LP;
    { float v[33];
#pragma unroll
        for (int j = 0; j < 33; ++j) { const int i = F.tid + 512 * j; v[j] = (i < LQ) ? src[i] : 0.f; }
#pragma unroll
        for (int j = 0; j < 33; ++j) { const int i = F.tid + 512 * j; if (i < LP) buf[i] = v[j]; } }
    __syncthreads();
    constexpr int PER = 33;
    const int s0 = F.tid * PER;
    float part = 0.f;
    for (int j = 0; j < PER; ++j) { const int i = s0 + j; if (i < LP) part += buf[i]; }
    float inc = part;
#pragma unroll
    for (int o = 1; o < 64; o <<= 1) { const float n = __shfl_up(inc, o); if (F.lane >= o) inc += n; }
    if (F.lane == 63) wt[F.wave] = inc;
    __syncthreads();
    float base = inc - part;
    for (int ww = 0; ww < F.wave; ++ww) base += wt[ww];
    float run = base;
    for (int j = 0; j < PER; ++j) { const int i = s0 + j; if (i < LP) { run += buf[i]; buf[i] = run; } }
    __syncthreads();
    for (int i = F.tid; i < LP; i += 512) dst[i] = buf[i];
    __syncthreads();
}

constexpr int AT_SUB = 16640;
constexpr int AT_BUF = 2 * AT_SUB;
constexpr int AT_WS = 2 * AT_BUF;
constexpr int AT_MISC = AT_WS + 2048;
__device__ __forceinline__ int crow(int r, int hi) { return (r & 3) + 8 * (r >> 2) + 4 * hi; }
typedef short v4i16_t __attribute__((ext_vector_type(4)));
__device__ __forceinline__ bf16x4 vtr(const LAS unsigned char* p) { return __builtin_bit_cast(bf16x4, __builtin_amdgcn_ds_read_tr16_b64_v4i16((LAS v4i16_t*)p)); }

__device__ __forceinline__ void attn_tile(const LAS unsigned char* B, int t, int wrow0, int lane, int r32, int hi, float cqb, float cw0, float thr, const bf16x8 (&qr)[4], float& l, f32x16 (&o)[2]) {
    const LAS float* ct = (const LAS float*)(B + 16384);
    if (64 * t <= wrow0 + 31 && cw0 - ct[63] >= thr) {
        f32x16 p0, p1;
#pragma unroll
        for (int rq = 0; rq < 4; ++rq) { const f32x4 c0 = *(const LAS f32x4*)(ct + 8 * rq + 4 * hi), c1 = *(const LAS f32x4*)(ct + 32 + 8 * rq + 4 * hi);
#pragma unroll
            for (int i = 0; i < 4; ++i) { p0[4 * rq + i] = cqb - c0[i]; p1[4 * rq + i] = cqb - c1[i]; } }
#pragma unroll
        for (int d0 = 0; d0 < 4; ++d0) {
            const bf16x8 a0 = *(const LAS bf16x8*)(B + (2 * d0 + hi) * 1024 + r32 * 16), a1 = *(const LAS bf16x8*)(B + (2 * d0 + hi) * 1024 + 512 + r32 * 16);
            p0 = __builtin_amdgcn_mfma_f32_32x32x16_bf16(a0, qr[d0], p0, 0, 0, 0);
            p1 = __builtin_amdgcn_mfma_f32_32x32x16_bf16(a1, qr[d0], p1, 0, 0, 0);
        }
        if (64 * t + 63 > wrow0) {
            const int qpos = wrow0 + r32, kb = 64 * t + 4 * hi;
#pragma unroll
            for (int r = 0; r < 16; ++r) { const int kv = kb + (r & 3) + 8 * (r >> 2); if (kv > qpos) p0[r] = -1.0e30f; if (kv + 32 > qpos) p1[r] = -1.0e30f; }
        }
        float sacc = 0.f;
#pragma unroll
        for (int r = 0; r < 16; ++r) { p0[r] = fexp2(p0[r]); p1[r] = fexp2(p1[r]); sacc += p0[r] + p1[r]; }
        l += sacc;
        bf16x8 pa[4];
#pragma unroll
        for (int s = 0; s < 4; ++s) { const f32x16& P = (s < 2) ? p0 : p1; const int h8 = 8 * (s & 1);
            v4u pk; pk.x = pk2(P[h8 + 0], P[h8 + 1]); pk.y = pk2(P[h8 + 2], P[h8 + 3]); pk.z = pk2(P[h8 + 4], P[h8 + 5]); pk.w = pk2(P[h8 + 6], P[h8 + 7]);
            pa[s] = __builtin_bit_cast(bf16x8, pk); }
        const LAS unsigned char* vp = B + 8192 + ((lane >> 4) & 1) * 32 + (lane & 3) * 8 + (4 * hi + ((lane & 15) >> 2)) * 64;
#pragma unroll
        for (int dq = 0; dq < 2; ++dq)
#pragma unroll
            for (int s = 0; s < 4; ++s) { const bf16x4 lo = vtr(vp + dq * 4096 + s * 1024), hh = vtr(vp + dq * 4096 + s * 1024 + 512);
                const bf16x8 vf = (bf16x8){lo[0], lo[1], lo[2], lo[3], hh[0], hh[1], hh[2], hh[3]};
                o[dq] = __builtin_amdgcn_mfma_f32_32x32x16_bf16(pa[s], vf, o[dq], 0, 0, 0); }
    }
}
__device__ __forceinline__ void attn_unit(const Frame& F, int b, int hd, int qb, float thr, float bq) {
    const int tid = F.tid, lane = F.lane, w = F.wave, r32 = lane & 31, hi = lane >> 5;
    const size_t rowb = (size_t)b * LP; const int q0 = qb * 256;
    const bf16* Qh = (const bf16*)(F.ws + WS_Q) + rowb * DM + hd * FD; const bf16* Kh = (const bf16*)(F.ws + WS_K) + rowb * DM + hd * FD; const bf16* Vh = (const bf16*)(F.ws + WS_V) + rowb * DM + hd * FD;
    bf16* Oh = (bf16*)(F.ws + WS_Q) + rowb * DM + hd * FD;
    const float* Cs = (const float*)(F.ws + WS_CC) + (size_t)(b * FH + hd) * LP;
    LAS unsigned char* L = F.lds; LAS float* wsf = (LAS float*)(L + AT_WS) + w * 64; LAS int* misc = (LAS int*)(L + AT_MISC);
    const int t_hi = (qb == 64) ? 256 : 4 * qb + 3;
    if (tid == 0) misc[0] = t_hi;
    __syncthreads();
    { const float ci0 = Cs[q0]; if (tid <= t_hi) { if (ci0 - Cs[64 * tid + 63] >= thr) __hip_atomic_fetch_min(misc, tid, __ATOMIC_RELAXED, __HIP_MEMORY_SCOPE_WORKGROUP); } }
    __syncthreads();
    const int t_lo = misc[0];
    bf16x8 qr[4];
#pragma unroll
    for (int d0 = 0; d0 < 4; ++d0) qr[d0] = *(const bf16x8*)(Qh + (size_t)(q0 + 32 * w + r32) * DM + 16 * d0 + 8 * hi);
    const int wrow0 = q0 + 32 * w;
    const float cq = Cs[wrow0 + r32], cqb = cq - bq, cw0 = __shfl(cq, 0);
    float l = 0.f; f32x16 o[2];
#pragma unroll
    for (int r = 0; r < 16; ++r) { o[0][r] = 0.f; o[1][r] = 0.f; }
    const int skv = tid >> 3, sc = tid & 7;
    const bf16* ksrc = Kh + (size_t)skv * DM + 8 * sc; const bf16* vsrc = Vh + (size_t)skv * DM + 8 * sc;
    const int kdst = sc * 1024 + skv * 16, vdst = 8192 + (sc >> 2) * 4096 + skv * 64 + (sc & 3) * 16;
#define AT_LOAD(tt) do { k0_ = *(const v4u*)(ksrc + (size_t)(tt) * 64 * DM); v0_ = *(const v4u*)(vsrc + (size_t)(tt) * 64 * DM); k1_ = *(const v4u*)(ksrc + (size_t)((tt) + 1) * 64 * DM); v1_ = *(const v4u*)(vsrc + (size_t)((tt) + 1) * 64 * DM); \
        if (tid < 128) c_ = Cs[64 * (tt) + tid]; } while (0)
#define AT_STORE(bufo) do { LAS unsigned char* Bn_ = L + (bufo) * AT_BUF; *(LAS v4u*)(Bn_ + kdst) = k0_; *(LAS v4u*)(Bn_ + vdst) = v0_; *(LAS v4u*)(Bn_ + AT_SUB + kdst) = k1_; *(LAS v4u*)(Bn_ + AT_SUB + vdst) = v1_; \
        if (tid < 128) *(LAS float*)(Bn_ + (tid >> 6) * AT_SUB + 16384 + 4 * (tid & 63)) = c_; } while (0)
    v4u k0_, v0_, k1_, v1_; float c_ = 0.f;
    const int p_hi = t_hi >> 1, p_lo = t_lo >> 1;
    AT_LOAD(2 * p_hi); AT_STORE(0);
    if (p_hi > p_lo) AT_LOAD(2 * p_hi - 2);
    __syncthreads();
    int cur = 0;
    const bool live = wrow0 < (qb == 64 ? LQ : 0x7fffffff);
    for (int pp = p_hi; pp >= p_lo; --pp) {
        const LAS unsigned char* B = L + cur * AT_BUF;
        if (live) { attn_tile(B + AT_SUB, 2 * pp + 1, wrow0, lane, r32, hi, cqb, cw0, thr, qr, l, o); attn_tile(B, 2 * pp, wrow0, lane, r32, hi, cqb, cw0, thr, qr, l, o); }
        if (pp > p_lo) { AT_STORE(cur ^ 1); if (pp - 1 > p_lo) AT_LOAD(2 * pp - 4); }
        __syncthreads(); cur ^= 1;
    }
#undef AT_LOAD
#undef AT_STORE
    { auto rr = __builtin_amdgcn_permlane32_swap(__float_as_uint(l), __float_as_uint(l), false, false); l = __uint_as_float(rr[0]) + __uint_as_float(rr[1]); }
    if (hi == 0) wsf[32 + r32] = l;
    asm volatile("s_waitcnt lgkmcnt(0)" ::: "memory");
    __builtin_amdgcn_wave_barrier();
#pragma unroll
    for (int rq = 0; rq < 4; ++rq) { const f32x4 lv = *(const LAS f32x4*)(wsf + 32 + 8 * rq + 4 * hi);
#pragma unroll
        for (int i = 0; i < 4; ++i) { const int r = 4 * rq + i; const float rl = frcp(lv[i]); bf16* op = Oh + (size_t)(wrow0 + crow(r, hi)) * DM + r32;
            op[0] = (bf16)f2bf(o[0][r] * rl); op[32] = (bf16)f2bf(o[1][r] * rl); } }
    __syncthreads();
}
__device__ __forceinline__ void attn_phase(const Frame& F) {
    float gq = fabsf(F.in[I_FOX_QN][F.lane]), gk = fabsf(F.in[I_FOX_KN][F.lane]);
#pragma unroll
    for (int o = 1; o < 64; o <<= 1) { gq = fmaxf(gq, __shfl_xor(gq, o)); gk = fmaxf(gk, __shfl_xor(gk, o)); }
    const float bq = 1.01f * C2 * FD * gq * gk, thr = -SKIP_T;
    for (int i = 0;; ++i) {
        const int id = i * F.G + F.vcu; if (id >= 65 * NBATCH * FH) break;
        int bh, qb; if (id < 64 * NBATCH * FH) { bh = id >> 6; qb = 63 - (id & 63); } else { bh = id - 64 * NBATCH * FH; qb = 64; }
        attn_unit(F, bh >> 4, bh & 15, qb, thr, bq);
    }
}
struct MainOrder {
    pg8::StaticOrder S;
    __device__ __forceinline__ void init(int N, int G, int c) { S.init(128 * 256, N, G, c); }
    __device__ __forceinline__ bool next(int i, pg8::Unit& u) const { if (!S.next(i, u)) return false; u.pm += (u.pm >= 64) ? 1 : 0; return true; }
    __device__ __forceinline__ void a_ready(const pg8::Unit&) const {}
    __device__ __forceinline__ void done(const pg8::Unit&) const {}
};
__device__ __forceinline__ int perm_qkv_row(int n) { return (n & ~255) + 128 * ((n >> 5) & 1) + 32 * ((n >> 6) & 3) + (n & 31); }
template <int KIND  >
__device__ __forceinline__ void skinny_gemm(const Frame& F, const bf16* __restrict__ A, const bf16* __restrict__ Bt, int N) {
    const int ntask = 2 * (N / 64), task = (int)blockIdx.x - (KIND == 0 ? 32 : 0);
    if (task < 0 || task >= ntask) return;
    const int b = task & 1, cg = task >> 1, i16 = F.lane & 15, g = F.lane >> 4;
    const size_t row0 = (size_t)b * LP + SEQ;
    const bf16* ap = A + (row0 + i16) * DM + 8 * g;
    const bf16* bp[4];
#pragma unroll
    for (int nb = 0; nb < 4; ++nb) { const int n = 64 * cg + 16 * nb + i16; bp[nb] = Bt + (size_t)(KIND == 0 ? perm_qkv_row(n) : n) * DM + 8 * g; }
    f32x4 acc[4];
#pragma unroll
    for (int nb = 0; nb < 4; ++nb) acc[nb] = (f32x4){0.f, 0.f, 0.f, 0.f};
#pragma unroll
    for (int kk = 0; kk < 4; ++kk) { const int ks = 4 * F.wave + kk; const bf16x8 af = *(const bf16x8*)(ap + 32 * ks);
#pragma unroll
        for (int nb = 0; nb < 4; ++nb) acc[nb] = __builtin_amdgcn_mfma_f32_16x16x32_bf16(af, *(const bf16x8*)(bp[nb] + 32 * ks), acc[nb], 0, 0, 0); }
    { LAS f32x4* red = (LAS f32x4*)F.lds;
#pragma unroll
        for (int nb = 0; nb < 4; ++nb) red[(F.wave * 4 + nb) * 64 + F.lane] = acc[nb];
        __syncthreads();
        if (F.wave == 0) {
#pragma unroll
            for (int nb = 0; nb < 4; ++nb) { f32x4 s = red[nb * 64 + F.lane];
#pragma unroll
                for (int ww = 1; ww < 8; ++ww) s += red[(ww * 4 + nb) * 64 + F.lane];
                acc[nb] = s; } }
        __syncthreads();
        if (F.wave != 0) return; }
    unsigned char* ws = F.ws;
    if (KIND == 0 || KIND == 3) { const float* RSTD = (const float*)(ws + WS_RSTD);
#pragma unroll
        for (int r = 0; r < 4; ++r) { const float sc = RSTD[row0 + 4 * g + r];
#pragma unroll
            for (int nb = 0; nb < 4; ++nb) acc[nb][r] *= sc; } }
    if (KIND == 0) {
        const int type = cg >> 4, head = cg & 15; bf16* dst = (bf16*)(ws + WS_Q) + (size_t)type * ((WS_K - WS_Q) / 2);
#pragma unroll
        for (int r = 0; r < 4; ++r) { float sc = 1.f;
            if (type < 2) { float ss = acc[0][r] * acc[0][r] + acc[1][r] * acc[1][r] + acc[2][r] * acc[2][r] + acc[3][r] * acc[3][r];
                ss += __shfl_xor(ss, 1); ss += __shfl_xor(ss, 2); ss += __shfl_xor(ss, 4); ss += __shfl_xor(ss, 8);
                sc = __builtin_amdgcn_rsqf(ss * (1.f / FD) + EPS); }
#pragma unroll
            for (int nb = 0; nb < 4; ++nb) { const int d = 16 * nb + i16; float v = acc[nb][r];
                if (type < 2) { const float gq = F.in[I_FOX_QN][d] * C2, gk = F.in[I_FOX_KN][d]; v *= sc * (type == 0 ? gq : gk); }
                dst[(row0 + 4 * g + r) * DM + head * FD + d] = (bf16)f2bf(v); } }
    } else if (KIND == 1 || KIND == 2) {
        bf16* H = (bf16*)(ws + WS_H);
#pragma unroll
        for (int r = 0; r < 4; ++r)
#pragma unroll
            for (int nb = 0; nb < 4; ++nb) { const int c = 64 * cg + 16 * nb + i16; const size_t row = row0 + 4 * g + r;
                const float base = bf2f(H[row * DM + c]);
                H[row * DM + c] = (bf16)f2bf(base + acc[nb][r]); }
    } else {
        const int type = cg >> 4; bf16* dst = (bf16*)(ws + WS_Q) + (size_t)(type == 0 ? 0 : (type == 2 ? 2 : 1)) * ((WS_K - WS_Q) / 2); float* LOGF = (float*)(ws + WS_LOGF);
#pragma unroll
        for (int nb = 0; nb < 4; ++nb) { const int c = 64 * (cg & 15) + 16 * nb + i16;
            float bias = 0.f, lb = 0.f;
            if (type == 1) { bias = F.in[I_HG_BF][c]; lb = frcp(1.f + fexp(F.in[I_HG_LB][c] - F.in[I_HG_LB][DM + c])); }
#pragma unroll
            for (int r = 0; r < 4; ++r) { const size_t off = (row0 + 4 * g + r) * DM + c; const float v = acc[nb][r];
                if (type == 1) { const float sg = frcp(1.f + fexp(-(v + bias))); LOGF[off] = __logf(lb + (1.f - lb) * sg); }
                else dst[off] = (bf16)f2bf(type == 2 ? v : silu(v)); } }
    }
}
constexpr int MOE_PSTART = MISC_OFF + 64, MOE_TEXP = MISC_OFF + 256, MOE_NTILE = MISC_OFF + 60;
__device__ __forceinline__ void moe_tables(const Frame& F, int layer) {
    LAS int* pstart = (LAS int*)(F.lds + MOE_PSTART); LAS int* texp = (LAS int*)(F.lds + MOE_TEXP); LAS int* ntile = (LAS int*)(F.lds + MOE_NTILE);
    __syncthreads();
    if (F.tid < NEXP) { const unsigned c = __hip_atomic_load(F.ctl + CW_CNT + layer * 2048 + F.tid * 16, RLX_AGENT); pstart[F.tid + 1] = (int)((c + 255u) >> 8) << 8; }
    __syncthreads();
    if (F.tid == 0) { int acc = 0; pstart[0] = 0;
        for (int e = 0; e < NEXP; ++e) { acc += pstart[e + 1]; pstart[e + 1] = acc; }
        ntile[0] = acc >> 8; }
    __syncthreads();
    const int nt = ntile[0];
    for (int t = F.tid; t < nt && t < XPAD_TILES; t += 512) { int e = 0;
        for (int j = 1; j < NEXP; ++j) e += (pstart[j] <= 256 * t) ? 1 : 0;
        texp[t] = e; }
    __syncthreads();
}
__device__ __forceinline__ void moe_gather(const Frame& F, int layer) {
    moe_tables(F, layer);
    const LAS int* pstart = (const LAS int*)(F.lds + MOE_PSTART);
    LAS unsigned* lh = (LAS unsigned*)F.lds; LAS unsigned* lbase = lh + 32;
    unsigned* TOK = (unsigned*)(F.ws + WS_TOK); int* SROW = (int*)(F.ws + WS_SROW); float* RS = (float*)(F.ws + WS_RS);
    if (F.tid < NEXP) lh[F.tid] = 0u;
    __syncthreads();
    const int i = F.vcu * 512 + F.tid; const bool act = i < NBATCH * LQ;
    int e1 = 0, e2 = 0; unsigned s1 = 0, s2 = 0; size_t row = 0; float rst = 0.f;
    if (act) { const int b = i / LQ, t = i - b * LQ; row = (size_t)b * LP + t;
        const unsigned ee = TOK[row * 8]; e1 = ee & 255; e2 = (ee >> 8) & 255; rst = __uint_as_float(TOK[row * 8 + 3]);
        s1 = __hip_atomic_fetch_add(lh + e1, 1u, __ATOMIC_RELAXED, __HIP_MEMORY_SCOPE_WORKGROUP);
        s2 = __hip_atomic_fetch_add(lh + e2, 1u, __ATOMIC_RELAXED, __HIP_MEMORY_SCOPE_WORKGROUP); }
    __syncthreads();
    if (F.tid < NEXP) { const unsigned n = lh[F.tid]; lbase[F.tid] = n ? __hip_atomic_fetch_add(F.ctl + CW_CNT + layer * 2048 + 1024 + F.tid * 16, n, RLX_AGENT) : 0u; }
    __syncthreads();
    if (act) { const int d1 = pstart[e1] + (int)(lbase[e1] + s1), d2 = pstart[e2] + (int)(lbase[e2] + s2);
        *(v2u*)(TOK + row * 8 + 4) = (v2u){(unsigned)d1, (unsigned)d2};
        SROW[d1] = (int)row; SROW[d2] = (int)row; RS[d1] = rst; RS[d2] = rst; }
    __syncthreads();
}
__device__ __forceinline__ void moe_range(const LAS unsigned char* lds, int& T0, int& nun) { const int nt = *(const LAS int*)(lds + MOE_NTILE), x = (int)blockIdx.x & 7;
    T0 = (nt * x) >> 3; nun = (((nt * (x + 1)) >> 3) - T0) * 4; }
constexpr int MOE_RIDX = MISC_OFF + 2048;
__device__ __forceinline__ void moe_ridx(const Frame& F) {
    const int* SROW = (const int*)(F.ws + WS_SROW); LAS int* ridx = (LAS int*)(F.lds + MOE_RIDX);
    const LAS int* pstart = (const LAS int*)(F.lds + MOE_PSTART);
    const int r = (int)blockIdx.x >> 3; int T0, nun; moe_range(F.lds, T0, nun);
    if (F.tid < 256) { int v[6];
#pragma unroll
        for (int i = 0; i < 6; ++i) { const int Lx = i * 32 + r; v[i] = (Lx < nun) ? SROW[(T0 + (Lx >> 2)) * 256 + F.tid] : 0; }
#pragma unroll
        for (int i = 0; i < 6; ++i) ridx[i * 256 + F.tid] = v[i]; }
    __syncthreads();
}
constexpr int RS_TAB = MISC_OFF + 8192;
template <class Sched> __device__ __forceinline__ void rs_preload(const Frame& F, const Sched& S, const float* __restrict__ src) {
    LAS float* tab = (LAS float*)(F.lds + RS_TAB);
    if (F.tid < 256) { float v[8];
#pragma unroll
        for (int i = 0; i < 8; ++i) { pg8::Unit u; v[i] = S.next(i, u) ? src[(size_t)u.pm * 256 + F.tid] : 0.f; }
#pragma unroll
        for (int i = 0; i < 8; ++i) tab[i * 256 + F.tid] = v[i]; }
    __syncthreads();
}
struct MoeOrder {
    const LAS int* texp; int T0, nun, r; unsigned* dep; bool samex;
    __device__ __forceinline__ void signal(int pm) const { if (threadIdx.x == 0) { if (samex) __hip_atomic_fetch_add(dep + pm * 16, 1u, __ATOMIC_RELAXED, __HIP_MEMORY_SCOPE_AGENT);
                                                                                    else __hip_atomic_fetch_add(dep + pm * 16, 1u, __ATOMIC_RELEASE, __HIP_MEMORY_SCOPE_AGENT); } }
    __device__ __forceinline__ void init(const LAS unsigned char* lds) { const LAS int* pstart = (const LAS int*)(lds + MOE_PSTART); texp = (const LAS int*)(lds + MOE_TEXP);
        r = (int)blockIdx.x >> 3; moe_range(lds, T0, nun); }
    __device__ __forceinline__ bool next(int i, pg8::Unit& u) const { const int Lx = i * 32 + r; if (Lx >= nun) return false; const int rt = T0 + (Lx >> 2); u.pm = rt; u.pn = texp[rt] * 4 + (Lx & 3); u.ord = i; return true; }
    __device__ __forceinline__ void a_ready(const pg8::Unit&) const {}
    __device__ __forceinline__ void done(const pg8::Unit&) const {}
};
constexpr int MOE_DLIST = MISC_OFF + 1440;
struct MoeDownOrder {
    const LAS int* texp; const LAS int* dl; int T0, nun; unsigned* dep; mutable int have;
    __device__ __forceinline__ void init(LAS unsigned char* lds, unsigned* dep_) { const LAS int* pstart = (const LAS int*)(lds + MOE_PSTART); texp = (const LAS int*)(lds + MOE_TEXP); dep = dep_; have = -1;
        const int r = (int)blockIdx.x >> 3, tid = (int)threadIdx.x; moe_range(lds, T0, nun);
        LAS int* cl = (LAS int*)(lds + MOE_DLIST); LAS int* dlw = cl + 32; dl = dlw;
        const int target = (3 * nun + 31) / 32;
        if (tid < 32) { const int nup = tid < nun ? (nun - tid + 31) / 32 : 0; cl[tid] = target > 2 * nup ? target - 2 * nup : 0; }
        __syncthreads();
        if (tid < 24) { int base = 0, off = 0;
            for (int rr = 0; rr < 32; ++rr) { const int c = cl[rr]; base += c < tid ? c : tid; off += (rr < r && c > tid) ? 1 : 0; }
            const int Lx = base + off; dlw[tid] = (tid < cl[r] && Lx < nun) ? Lx : -1; }
        if (tid == 0) { __builtin_amdgcn_fence(__ATOMIC_ACQUIRE, "agent"); asm volatile("s_waitcnt vmcnt(0)" ::: "memory"); }
        __syncthreads(); }
    __device__ __forceinline__ bool next(int i, pg8::Unit& u) const { if (i >= 24) return false; const int Lx = dl[i]; if (Lx < 0) return false; const int rt = T0 + (Lx >> 2); u.pm = rt; u.pn = texp[rt] * 4 + (Lx & 3); u.ord = i; return true; }
    __device__ __forceinline__ void a_ready(const pg8::Unit& u) const {
        if (u.pm != have) {
            if (threadIdx.x == 0) { int spin = 0; while (__hip_atomic_load(dep + u.pm * 16, __ATOMIC_RELAXED, __HIP_MEMORY_SCOPE_AGENT) < 4u && ++spin < (1 << 24)) __builtin_amdgcn_s_sleep(2);
                asm volatile("" ::: "memory"); }
            __builtin_amdgcn_s_barrier();
            have = u.pm; }
    }
    __device__ __forceinline__ void done(const pg8::Unit&) const {}
};
constexpr int HG_TS = 288;
constexpr int HG_RS = 272;
template <int SH> __device__ __forceinline__ float row_shr(float x) {
    return __builtin_bit_cast(float, __builtin_amdgcn_update_dpp(0, __builtin_bit_cast(int, x), 0x110 + SH, 0xF, 0xF, true)); }
__device__ __forceinline__ float row_scan16(float x) { x += row_shr<1>(x); x += row_shr<2>(x); x += row_shr<4>(x); x += row_shr<8>(x); return x; }

struct HgLf { f32x4 a[4], c[4]; };
__device__ __forceinline__ void hg_load_lf(const float* __restrict__ lfrow, int g, HgLf& R) {
#pragma unroll
    for (int st = 0; st < 4; ++st) { R.a[st] = *(const f32x4*)(lfrow + 32 * st + 8 * g); R.c[st] = *(const f32x4*)(lfrow + 32 * st + 8 * g + 4); }
}
__device__ __forceinline__ void hg_scan_vals(const HgLf& R, LAS float* tot, int w, int t, int g, float (&kk)[4][8], float (&bl)[4][8]) {
#pragma unroll
    for (int st = 0; st < 4; ++st) { const f32x4 a = R.a[st], c = R.c[st];
        const float lf[8] = {a.x, a.y, a.z, a.w, c.x, c.y, c.z, c.w};
#pragma unroll
        for (int j = 0; j < 8; ++j) { kk[st][j] = 1.f - fexp(lf[j]); bl[st][j] = row_scan16(lf[j]); }
        if (t == 15) { *(LAS f32x4*)(tot + w * 128 + 32 * st + 8 * g) = (f32x4){bl[st][0], bl[st][1], bl[st][2], bl[st][3]};
                       *(LAS f32x4*)(tot + w * 128 + 32 * st + 8 * g + 4) = (f32x4){bl[st][4], bl[st][5], bl[st][6], bl[st][7]}; } }
}
__device__ __forceinline__ void hg_scan(const float* __restrict__ lfrow, LAS float* tot, int w, int t, int g, float (&kk)[4][8], float (&bl)[4][8]) {
    HgLf R; hg_load_lf(lfrow, g, R); hg_scan_vals(R, tot, w, t, g, kk, bl); }
__device__ __forceinline__ void lds_row8(const LAS float* p, float (&v)[8]) { const f32x4 a = *(const LAS f32x4*)p, c = *(const LAS f32x4*)(p + 4);
    v[0] = a.x; v[1] = a.y; v[2] = a.z; v[3] = a.w; v[4] = c.x; v[5] = c.y; v[6] = c.z; v[7] = c.w; }
__device__ __forceinline__ void hg_stage_v(const Frame& F, const bf16* __restrict__ vsrc, LAS unsigned char* img) {
#pragma unroll
    for (int p = 0; p < 4; ++p) { const int idx = F.tid + 512 * p, row = idx >> 4, c16 = idx & 15;
        *(LAS v4u*)(img + row * HG_TS + c16 * 16) = *(const v4u*)(vsrc + (size_t)row * DM + 8 * c16); }
}

constexpr int A1_KT = 0, A1_V = 128 * HG_TS, A1_TOT = 2 * 128 * HG_TS;
struct A1Pre { HgLf lf; v4u v[4]; };
__device__ __forceinline__ void hg_a1_prefetch(const Frame& F, int bh, int c, A1Pre& P) {
    const int w = F.wave, t = F.lane & 15, g = F.lane >> 4, b = bh >> 3, hd = bh & 7;
    const size_t row0 = (size_t)b * LP + 128 * c;
    hg_load_lf((const float*)(F.ws + WS_LOGF) + (row0 + 16 * w + t) * DM + hd * HK, g, P.lf);
    const bf16* vsrc = (const bf16*)(F.ws + WS_V) + row0 * DM + hd * HV;
#pragma unroll
    for (int p = 0; p < 4; ++p) { const int idx = F.tid + 512 * p, row = idx >> 4, c16 = idx & 15; P.v[p] = *(const v4u*)(vsrc + (size_t)row * DM + 8 * c16); }
}
__device__ __forceinline__ void hg_a1_unit(const Frame& F, int bh, int c, const A1Pre& P) {
    const int w = F.wave, t = F.lane & 15, g = F.lane >> 4;
    LAS unsigned char* L = F.lds; LAS float* tot = (LAS float*)(L + A1_TOT);
    float kk[4][8], bl[4][8];
#pragma unroll
    for (int p = 0; p < 4; ++p) { const int idx = F.tid + 512 * p, row = idx >> 4, c16 = idx & 15; *(LAS v4u*)(L + A1_V + row * HG_TS + c16 * 16) = P.v[p]; }
    hg_scan_vals(P.lf, tot, w, t, g, kk, bl);
}
__device__ __forceinline__ void hg_a1_rest(const Frame& F, int bh, int c, float (&kk)[4][8], float (&bl)[4][8]) {
    const int w = F.wave, t = F.lane & 15, g = F.lane >> 4;
    LAS unsigned char* L = F.lds; LAS float* tot = (LAS float*)(L + A1_TOT);
    __syncthreads();
#pragma unroll
    for (int st = 0; st < 4; ++st) { float e[8]; lds_row8(tot + w * 128 + 32 * st + 8 * g, e);
        for (int ww = w + 1; ww < 8; ++ww) { float x[8]; lds_row8(tot + ww * 128 + 32 * st + 8 * g, x);
#pragma unroll
            for (int j = 0; j < 8; ++j) e[j] += x[j]; }
        v4u o; float r[8];
#pragma unroll
        for (int j = 0; j < 8; ++j) r[j] = kk[st][j] * fexp(e[j] - bl[st][j]);
        o.x = pk2(r[0], r[1]); o.y = pk2(r[2], r[3]); o.z = pk2(r[4], r[5]); o.w = pk2(r[6], r[7]);
        *(LAS v4u*)(L + A1_KT + (16 * w + t) * HG_TS + (32 * st + 8 * g) * 2) = o; }
    if (F.tid < 128) { float s = 0.f;
#pragma unroll
        for (int ww = 0; ww < 8; ++ww) s += tot[ww * 128 + F.tid];
        ((float*)(F.ws + WS_BE))[(size_t)(bh * 128 + c) * 128 + F.tid] = s; }
    __syncthreads();
    f32x4 acc[8];
#pragma unroll
    for (int kb = 0; kb < 8; ++kb) acc[kb] = (f32x4){0.f, 0.f, 0.f, 0.f};
    const int i16 = F.lane & 15;
    const LAS unsigned char* ap = L + A1_V + (8 * g + (i16 >> 2)) * HG_TS + (16 * w + 4 * (i16 & 3)) * 2;
    const LAS unsigned char* bp = L + A1_KT + (8 * g + (i16 >> 2)) * HG_TS + (4 * (i16 & 3)) * 2;
#pragma unroll
    for (int ts = 0; ts < 4; ++ts) {
        const bf16x4 a0 = vtr(ap + 32 * ts * HG_TS), a1 = vtr(ap + (32 * ts + 4) * HG_TS);
        const bf16x8 af = (bf16x8){a0[0], a0[1], a0[2], a0[3], a1[0], a1[1], a1[2], a1[3]};
#pragma unroll
        for (int kb = 0; kb < 8; ++kb) { const bf16x4 b0 = vtr(bp + 32 * ts * HG_TS + 32 * kb), b1 = vtr(bp + (32 * ts + 4) * HG_TS + 32 * kb);
            const bf16x8 bfr = (bf16x8){b0[0], b0[1], b0[2], b0[3], b1[0], b1[1], b1[2], b1[3]};
            acc[kb] = __builtin_amdgcn_mfma_f32_16x16x32_bf16(af, bfr, acc[kb], 0, 0, 0); }
    }
    float* S = (float*)(F.ws + WS_SLOC) + (size_t)(bh * 128 + c) * (HV * HK);
#pragma unroll
    for (int kb = 0; kb < 8; ++kb)
#pragma unroll
        for (int r = 0; r < 4; ++r) S[(16 * w + 4 * g + r) * HK + 16 * kb + i16] = acc[kb][r];
    __syncthreads();
}
__device__ __forceinline__ void hg_a1_phase(const Frame& F) {
    int id = F.vcu; if (id >= 16 * 128) return;
    A1Pre P; hg_a1_prefetch(F, id >> 7, id & 127, P);
    for (;;) {
        __builtin_amdgcn_s_waitcnt(0x0F70);
        float kk[4][8], bl[4][8];
        { const int w = F.wave, t = F.lane & 15, g = F.lane >> 4; LAS unsigned char* L = F.lds;
#pragma unroll
            for (int p = 0; p < 4; ++p) { const int idx = F.tid + 512 * p, row = idx >> 4, c16 = idx & 15; *(LAS v4u*)(L + A1_V + row * HG_TS + c16 * 16) = P.v[p]; }
            hg_scan_vals(P.lf, (LAS float*)(L + A1_TOT), w, t, g, kk, bl); }
        const int idn = id + F.G;
        if (idn < 16 * 128) hg_a1_prefetch(F, idn >> 7, idn & 127, P);
        hg_a1_rest(F, id >> 7, id & 127, kk, bl);
        id = idn; if (id >= 16 * 128) break;
    }
}
__device__ __forceinline__ void hg_a2_phase(const Frame& F) {
    const int gt = blockIdx.x * 256 + (F.tid & 255), bh = (blockIdx.x * 256) >> 12;
    LAS float* bel = (LAS float*)F.lds;
    { const float* BE = (const float*)(F.ws + WS_BE) + (size_t)bh * 128 * 128;
        f32x4 v[8];
#pragma unroll
        for (int j = 0; j < 8; ++j) v[j] = *(const f32x4*)(BE + 4 * (F.tid + 512 * j));
#pragma unroll
        for (int j = 0; j < 8; ++j) *(LAS f32x4*)(bel + 4 * (F.tid + 512 * j)) = v[j]; }
    __syncthreads();
    if (F.tid < 256) {
        const int kq = gt & 31, dv = (gt >> 5) & 127;
        const float* S = (const float*)(F.ws + WS_SLOC) + (size_t)bh * 128 * (HV * HK) + dv * HK + 4 * kq;
        bf16* ST = (bf16*)(F.ws + WS_ST) + (size_t)bh * 129 * (HV * HK) + dv * HK + 4 * kq;
        f32x4 st = (f32x4){0.f, 0.f, 0.f, 0.f};
        f32x4 A[8], B[8];
#pragma unroll
        for (int j = 0; j < 8; ++j) A[j] = *(const f32x4*)(S + (size_t)j * (HV * HK));
#define A2_BATCH(CUR, NXT, nb) do { __builtin_amdgcn_s_waitcnt(0x0F70); \
        if ((nb) + 1 < 16) { _Pragma("unroll") for (int j = 0; j < 8; ++j) NXT[j] = *(const f32x4*)(S + (size_t)(8 * ((nb) + 1) + j) * (HV * HK)); } \
        _Pragma("unroll") for (int j = 0; j < 8; ++j) { const int c = 8 * (nb) + j; \
            *(v2u*)(ST + (size_t)c * (HV * HK)) = (v2u){pk2(st.x, st.y), pk2(st.z, st.w)}; \
            const f32x4 be = *(const LAS f32x4*)(bel + c * 128 + 4 * kq), s = CUR[j]; \
            st.x = fexp(be.x) * st.x + s.x; st.y = fexp(be.y) * st.y + s.y; st.z = fexp(be.z) * st.z + s.z; st.w = fexp(be.w) * st.w + s.w; } } while (0)
        for (int nb = 0; nb < 16; nb += 2) { A2_BATCH(A, B, nb); A2_BATCH(B, A, nb + 1); }
#undef A2_BATCH
        *(v2u*)(ST + (size_t)128 * (HV * HK)) = (v2u){pk2(st.x, st.y), pk2(st.z, st.w)};
    }
    __syncthreads();
}
constexpr int A3_KH = 0, A3_V = 128 * HG_RS, A3_ST = A3_V + 128 * HG_TS, A3_TOT = A3_ST + 128 * HG_RS, A3_ET = A3_TOT + 4096, A3_STG = 0, A3_STG_W = 16 * 528;
__device__ __forceinline__ void hg_a3_unit(const Frame& F, int bh, int c) {
    const int w = (F.wave & 1) ? 7 - (F.wave >> 1) : (F.wave >> 1), t = F.lane & 15, g = F.lane >> 4, b = bh >> 3, hd = bh & 7;
    const size_t row0 = (size_t)b * LP + 128 * c;
    LAS unsigned char* L = F.lds; LAS float* tot = (LAS float*)(L + A3_TOT);
    float kk[4][8], bl[4][8];
    hg_stage_v(F, (const bf16*)(F.ws + WS_V) + row0 * DM + hd * HV, L + A3_V);
    { const bf16* ssrc = (const bf16*)(F.ws + WS_ST) + (size_t)(bh * 129 + c) * (HV * HK);
#pragma unroll
        for (int p = 0; p < 4; ++p) { const int idx = F.tid + 512 * p, row = idx >> 4, c16 = idx & 15;
            *(LAS v4u*)(L + A3_ST + row * HG_RS + c16 * 16) = *(const v4u*)(ssrc + (size_t)row * HK + 8 * c16); } }
    hg_scan((const float*)(F.ws + WS_LOGF) + (row0 + 16 * w + t) * DM + hd * HK, tot, w, t, g, kk, bl);
    LAS float* etab = (LAS float*)(L + A3_ET);
    if (t == 15) {
#pragma unroll
        for (int st = 0; st < 4; ++st) { *(LAS f32x4*)(etab + w * 128 + 32 * st + 8 * g) = (f32x4){fexp(bl[st][0]), fexp(bl[st][1]), fexp(bl[st][2]), fexp(bl[st][3])};
            *(LAS f32x4*)(etab + w * 128 + 32 * st + 8 * g + 4) = (f32x4){fexp(bl[st][4]), fexp(bl[st][5]), fexp(bl[st][6]), fexp(bl[st][7])}; } }
    float qd[4][8];
    { const bf16* qrow = (const bf16*)(F.ws + WS_Q) + (row0 + 16 * w + t) * DM + hd * HK;
#pragma unroll
        for (int st = 0; st < 4; ++st) { const v4u u = *(const v4u*)(qrow + 32 * st + 8 * g);
            const float q[8] = {bflo(u.x), bfhi(u.x), bflo(u.y), bfhi(u.y), bflo(u.z), bfhi(u.z), bflo(u.w), bfhi(u.w)};
            float e[8]; lds_row8(tot + w * 128 + 32 * st + 8 * g, e);
            v4u o; float r[8];
#pragma unroll
            for (int j = 0; j < 8; ++j) { r[j] = kk[st][j] * fexp(e[j] - bl[st][j]); qd[st][j] = q[j] * fexp(bl[st][j]); }
            o.x = pk2(r[0], r[1]); o.y = pk2(r[2], r[3]); o.z = pk2(r[4], r[5]); o.w = pk2(r[6], r[7]);
            *(LAS v4u*)(L + A3_KH + (16 * w + t) * HG_RS + (32 * st + 8 * g) * 2) = o; } }
    __syncthreads();
    v4u gpre[4];
    { const int rr = F.lane >> 2, seg = F.lane & 3; const bf16* gs = (const bf16*)(F.ws + WS_K) + (row0 + 16 * w + rr) * DM + hd * HV + 32 * seg;
#pragma unroll
        for (int q = 0; q < 4; ++q) gpre[q] = *(const v4u*)(gs + 8 * q); }
    f32x4 o[8];
#pragma unroll
    for (int d = 0; d < 8; ++d) o[d] = (f32x4){0.f, 0.f, 0.f, 0.f};
    const int i16 = F.lane & 15;
    {
        bf16x8 aq[4];
#pragma unroll
        for (int st = 0; st < 4; ++st) { float e[8];
#pragma unroll
            for (int j = 0; j < 8; ++j) e[j] = 0.f;
            for (int ww = 0; ww < w; ++ww) { float x[8]; lds_row8(tot + ww * 128 + 32 * st + 8 * g, x);
#pragma unroll
                for (int j = 0; j < 8; ++j) e[j] += x[j]; }
            v4u pk; pk.x = pk2(qd[st][0] * fexp(e[0]), qd[st][1] * fexp(e[1])); pk.y = pk2(qd[st][2] * fexp(e[2]), qd[st][3] * fexp(e[3]));
            pk.z = pk2(qd[st][4] * fexp(e[4]), qd[st][5] * fexp(e[5])); pk.w = pk2(qd[st][6] * fexp(e[6]), qd[st][7] * fexp(e[7]));
            aq[st] = __builtin_bit_cast(bf16x8, pk); }
        const LAS unsigned char* sp = L + A3_ST + i16 * HG_RS + 16 * g;
#pragma unroll
        for (int d = 0; d < 8; ++d)
#pragma unroll
            for (int st = 0; st < 4; ++st) { const bf16x8 bfr = *(const LAS bf16x8*)(sp + 16 * d * HG_RS + 64 * st);
                o[d] = __builtin_amdgcn_mfma_f32_16x16x32_bf16(aq[st], bfr, o[d], 0, 0, 0); }
    }
    {
        float dsc[4][8];
#pragma unroll
        for (int st = 0; st < 4; ++st) { float x[8]; lds_row8(tot + w * 128 + 32 * st + 8 * g, x);
#pragma unroll
            for (int j = 0; j < 8; ++j) dsc[st][j] = fexp(fminf(-x[j], 85.f)); }
        const LAS unsigned char* kp = L + A3_KH + i16 * HG_RS + 16 * g;
        const LAS unsigned char* vp = L + A3_V + (4 * g + (i16 >> 2)) * HG_TS + (4 * (i16 & 3)) * 2;
        for (int j = w; j >= 0; --j) {
            f32x4 pt = (f32x4){0.f, 0.f, 0.f, 0.f};
#pragma unroll
            for (int st = 0; st < 4; ++st) {
                v4u pk; pk.x = pk2(qd[st][0] * dsc[st][0], qd[st][1] * dsc[st][1]); pk.y = pk2(qd[st][2] * dsc[st][2], qd[st][3] * dsc[st][3]);
                pk.z = pk2(qd[st][4] * dsc[st][4], qd[st][5] * dsc[st][5]); pk.w = pk2(qd[st][6] * dsc[st][6], qd[st][7] * dsc[st][7]);
                const bf16x8 kf = *(const LAS bf16x8*)(kp + 16 * j * HG_RS + 64 * st);
                pt = __builtin_amdgcn_mfma_f32_16x16x32_bf16(kf, __builtin_bit_cast(bf16x8, pk), pt, 0, 0, 0); }
            if (j == w) {
#pragma unroll
                for (int r = 0; r < 4; ++r) if (4 * g + r > i16) pt[r] = 0.f; }
            const v2u pp = (v2u){pk2(pt[0], pt[1]), pk2(pt[2], pt[3])};
            const bf16x4 pa = __builtin_bit_cast(bf16x4, pp);
#pragma unroll
            for (int d = 0; d < 8; ++d) { const bf16x4 vb = vtr(vp + 16 * j * HG_TS + 32 * d);
                o[d] = __builtin_amdgcn_mfma_f32_16x16x16bf16_1k(pa, vb, o[d], 0, 0, 0); }
            if (j == w) {
#pragma unroll
                for (int st = 0; st < 4; ++st)
#pragma unroll
                    for (int jj = 0; jj < 8; ++jj) dsc[st][jj] = 1.f;
            } else {
#pragma unroll
                for (int st = 0; st < 4; ++st) { float x[8]; lds_row8(etab + j * 128 + 32 * st + 8 * g, x);
#pragma unroll
                    for (int jj = 0; jj < 8; ++jj) dsc[st][jj] *= x[jj]; } }
        }
    }
    float rs[4];
#pragma unroll
    for (int r = 0; r < 4; ++r) { float s = 0.f;
#pragma unroll
        for (int d = 0; d < 8; ++d) s += o[d][r] * o[d][r];
        s += __shfl_xor(s, 1); s += __shfl_xor(s, 2); s += __shfl_xor(s, 4); s += __shfl_xor(s, 8);
        rs[r] = __builtin_amdgcn_rsqf(s * (1.f / HV) + EPS); }
    const float* go = F.in[I_HG_ON];
    __syncthreads();
    LAS float* stg = (LAS float*)(L + A3_STG + w * A3_STG_W);
#pragma unroll
    for (int d = 0; d < 8; ++d) { const float gv = go[16 * d + i16];
#pragma unroll
        for (int r = 0; r < 4; ++r) stg[(4 * g + r) * 132 + 16 * d + i16] = o[d][r] * rs[r] * gv; }
    asm volatile("s_waitcnt lgkmcnt(0)" ::: "memory");
    __builtin_amdgcn_wave_barrier();
    { const int rr = F.lane >> 2, seg = F.lane & 3; const size_t orow = (row0 + 16 * w + rr) * DM + hd * HV + 32 * seg;
        const bf16* gs = (const bf16*)(F.ws + WS_K) + orow; bf16* og = (bf16*)(F.ws + WS_OG) + orow;
#pragma unroll
        for (int q = 0; q < 4; ++q) { const v4u gu = gpre[q]; float x[8]; lds_row8(stg + rr * 132 + 32 * seg + 8 * q, x);
            v4u ou; ou.x = pk2(x[0] * bflo(gu.x), x[1] * bfhi(gu.x)); ou.y = pk2(x[2] * bflo(gu.y), x[3] * bfhi(gu.y));
            ou.z = pk2(x[4] * bflo(gu.z), x[5] * bfhi(gu.z)); ou.w = pk2(x[6] * bflo(gu.w), x[7] * bfhi(gu.w));
            *(v4u*)(og + 8 * q) = ou; } }
    __syncthreads();
}
__device__ __forceinline__ void hg_a3_phase(const Frame& F) {
    for (int i = 0;; ++i) { const int id = i * F.G + F.vcu; if (id >= 16 * 129) break;
        if (id < 16 * 128) hg_a3_unit(F, id >> 7, id & 127); else hg_a3_unit(F, id - 16 * 128, 128); }
}
constexpr int NPHASE = 21;
struct Args { const float* in[21]; float* out; unsigned char* ws; int ph_lo, ph_hi, li, pad; };
__global__ void __launch_bounds__(512, 2) hybrid_fwd(Args args) {
    extern __shared__ __attribute__((aligned(16))) unsigned char lds_raw[];
    Frame F;
    F.lds = (LAS unsigned char*)lds_raw; F.ws = args.ws; F.ctl = (unsigned*)(args.ws + WS_CTL);
    F.tid = threadIdx.x; F.lane = F.tid & 63; F.wave = __builtin_amdgcn_readfirstlane(F.tid >> 6);
    F.G = gridDim.x; { const int bx = blockIdx.x; F.vcu = (F.G % 8 == 0) ? (bx % 8) * (F.G / 8) + bx / 8 : bx; }
#pragma unroll
    for (int i = 0; i < 21; ++i) F.in[i] = args.in[i];
    F.out = args.out;
    for (int u = F.tid; u < (LDS_BYTES - MISC_OFF) / 4; u += 512) ((LAS unsigned*)(F.lds + MISC_OFF))[u] = 0u;
    __syncthreads();
    XcdBarrier bar = xcd_barrier_post(F.ctl + CW_BAR + args.li * XCD_BAR_WORDS, (volatile LAS unsigned*)(F.lds + MISC_OFF));
    if (F.tid == 0) __hip_atomic_fetch_or(F.ctl + CW_XMAP + args.li * 128 + ((int)blockIdx.x & 7) * 16, 1u << bar.x, __ATOMIC_RELAXED, __HIP_MEMORY_SCOPE_AGENT);
    int nbar = 0;
    const int lo = args.ph_lo, hi = args.ph_hi;
#define IN(k) (lo <= (k) && (k) < hi)
#define SEAM(k) do { if (IN(k) && IN((k) + 1)) { xcd_barrier(bar); nbar = 1; } } while (0)
    unsigned char* ws = F.ws;
    bf16* H = (bf16*)(ws + WS_H); const float* RSTD = (const float*)(ws + WS_RSTD);
    bf16* WSM = (bf16*)(ws + WS_WSM);

    if (IN(0)) { p0_prologue(F); } SEAM(0);
    if (IN(1)) { t_phase<0, 1, 1, false>(F, F.in[I_FOX_NORM], WSM, WSM + 16384, 0); } SEAM(1);
    if (IN(2)) { fox_scan(F); skinny_gemm<0>(F, H, (const bf16*)(ws + WS_WQKV), 3 * DM);
        pg8::Gemm g{H, (const bf16*)(ws + WS_WQKV), MP, 3 * DM, DM}; MainOrder S; S.init(3 * DM, F.G, (int)blockIdx.x);
        rs_preload(F, S, RSTD); EpiQKV E{(bf16*)(ws + WS_Q), F.in[I_FOX_QN], F.in[I_FOX_KN], (const LAS float*)(F.lds + RS_TAB)};
        pg8::gemm_phase<EpiQKV, MainOrder, true, true>(F.lds, g, S, E); } SEAM(2);
    if (IN(3)) { const bool first = (F.vcu & 1) != 0; if (first) p0_moe_weights(F); __syncthreads(); attn_phase(F); __syncthreads(); if (!first) p0_moe_weights(F); } SEAM(3);
    if (IN(4)) { skinny_gemm<2>(F, (const bf16*)(ws + WS_Q), (const bf16*)(ws + WS_WFO), DM);
        pg8::Gemm g{(const bf16*)(ws + WS_Q), (const bf16*)(ws + WS_WFO), MP, DM, DM}; MainOrder S; S.init(DM, F.G, (int)blockIdx.x);
        EpiResid E{H}; pg8::gemm_phase<EpiResid, MainOrder, true, true>(F.lds, g, S, E); } SEAM(4);
#define MOE_PHASES(layer, pb) \
    if (IN(pb)) { const bf16* wh = WSM + 32768 + (size_t)(layer) * 98304; t_phase<1, 3, 2, false>(F, F.in[I_MOE_NORM] + (layer) * DM, wh, wh + 49152, (layer)); } SEAM(pb); \
    if (IN((pb) + 1)) { moe_gather(F, (layer)); } SEAM((pb) + 1); \
    if (IN((pb) + 2)) { moe_tables(F, (layer)); moe_ridx(F); \
        MoeOrder S; S.init(F.lds); S.dep = F.ctl + CW_DEP + (layer) * 8192; \
        { const unsigned xm = __hip_atomic_load(F.ctl + CW_XMAP + args.li * 128 + ((int)blockIdx.x & 7) * 16, __ATOMIC_RELAXED, __HIP_MEMORY_SCOPE_AGENT); S.samex = nbar > 0 && __builtin_popcount(xm) == 1; } \
        pg8::Gemm g{H, (const bf16*)(ws + WS_WUP) + (size_t)(layer) * NEXP * DM * DM, 0, 0, DM}; \
        rs_preload(F, S, (const float*)(ws + WS_RS)); EpiUp E{(bf16*)(ws + WS_ACT), (const LAS float*)(F.lds + RS_TAB)}; pg8::gemm_phase_g<EpiUp, MoeOrder>(F.lds, g, S, E, (const LAS int*)(F.lds + MOE_RIDX)); \
        MoeDownOrder SD; SD.init(F.lds, F.ctl + CW_DEP + (layer) * 8192); \
        pg8::Gemm g2{(const bf16*)(ws + WS_ACT), (const bf16*)(ws + WS_WDN) + (size_t)(layer) * NEXP * DM * DEXP, 0, 0, DEXP}; \
        EpiDown E2{(bf16*)(ws + WS_XPAD)}; pg8::gemm_phase<EpiDown, MoeDownOrder, true, true>(F.lds, g2, SD, E2); } \
    SEAM((pb) + 3);
    MOE_PHASES(0, 5)
    if (IN(9)) { t_phase<2, 0, 0, false>(F, F.in[I_HG_NORM], nullptr, nullptr, 0); } SEAM(9);
    if (IN(10)) { skinny_gemm<3>(F, H, (const bf16*)(ws + WS_WHI), 4 * DM);
        pg8::Gemm g{H, (const bf16*)(ws + WS_WHI), MP, 4 * DM, DM}; MainOrder S; S.init(4 * DM, F.G, (int)blockIdx.x);
        rs_preload(F, S, RSTD); EpiHgIn E{(bf16*)(ws + WS_Q), (float*)(ws + WS_LOGF), F.in[I_HG_BF], F.in[I_HG_LB], (const LAS float*)(F.lds + RS_TAB)};
        pg8::gemm_phase<EpiHgIn, MainOrder, true, true>(F.lds, g, S, E); } SEAM(10);
    if (IN(11)) { hg_a1_phase(F); } SEAM(11);
    if (IN(12)) { hg_a2_phase(F); } SEAM(12);
    if (IN(13)) { hg_a3_phase(F); } SEAM(13);
    if (IN(14)) { skinny_gemm<2>(F, (const bf16*)(ws + WS_OG), (const bf16*)(ws + WS_WHO), DM);
        pg8::Gemm g{(const bf16*)(ws + WS_OG), (const bf16*)(ws + WS_WHO), MP, DM, DM}; MainOrder S; S.init(DM, F.G, (int)blockIdx.x);
        EpiResid E{H}; pg8::gemm_phase<EpiResid, MainOrder, true, true>(F.lds, g, S, E); } SEAM(14);
    MOE_PHASES(1, 15)
    if (IN(19)) { t_phase<2, 0, 0, true>(F, nullptr, nullptr, nullptr, 0); }
    if (IN(20)) { t_phase<1, 0, 0, true>(F, nullptr, nullptr, nullptr, 0); }
    if (lo == 26) {
        const unsigned* TOK = (const unsigned*)(ws + WS_TOK); const bf16* Y = (const bf16*)(ws + WS_XPAD);
        for (size_t i = (size_t)blockIdx.x * 512 + F.tid; i < (size_t)NBATCH * SEQ * DM; i += (size_t)F.G * 512) {
            const size_t rr = i >> 10; const int c = (int)(i & 1023); const size_t b = rr / SEQ, t = rr % SEQ + NMETA; const size_t row = b * LP + t;
            F.out[i] = c < 512 ? 10.f * __builtin_bit_cast(float, TOK[row * 8 + 1]) : 10.f * __builtin_bit_cast(float, TOK[row * 8 + 2]); }
    }
    if (lo == 25) {
        const float* src = (const float*)(ws + WS_CC);
        for (size_t i = (size_t)blockIdx.x * 512 + F.tid; i < (size_t)NBATCH * SEQ * DM; i += (size_t)F.G * 512) {
            const size_t rr = i >> 10; const int c = (int)(i & 1023); const size_t b = rr / SEQ, t = rr % SEQ + NMETA;
            F.out[i] = src[(b * FH + (c & 15)) * LP + t] + (c >= 16 ? 1.0f : 0.f); }
    }
    if (lo >= 21 && lo <= 24) {
        const bf16* src = (const bf16*)(ws + (lo == 21 ? WS_Q : lo == 22 ? WS_K : lo == 23 ? WS_V : WS_XN));
        for (size_t i = (size_t)blockIdx.x * 512 + F.tid; i < (size_t)NBATCH * SEQ * DM; i += (size_t)F.G * 512) {
            const size_t rr = i >> 10; const int c = (int)(i & 1023); const size_t b = rr / SEQ, t = rr % SEQ + NMETA;
            F.out[i] = bf2f(src[(b * LP + t) * DM + c]); }
    }
#undef IN
#undef SEAM
}

extern "C" void kernel_launch(void* const* d_in, const int* in_sizes, int n_in, void* d_out, int out_size, void* d_ws, size_t ws_size, hipStream_t stream) {
    static int grid = 0;
    if (grid == 0) {
        if (n_in != 21 || out_size != NBATCH * SEQ * DM || ws_size < WS_END) { fprintf(stderr, "kernel_launch: unexpected shapes (n_in %d out %d ws %zu)\n", n_in, out_size, ws_size); grid = -1; return; }
        int dev = 0, cus = 0, per_cu = 0;
        if (hipGetDevice(&dev) != hipSuccess || hipDeviceGetAttribute(&cus, hipDeviceAttributeMultiprocessorCount, dev) != hipSuccess) { grid = -1; return; }
        if (hipFuncSetAttribute((const void*)hybrid_fwd, hipFuncAttributeMaxDynamicSharedMemorySize, LDS_BYTES) != hipSuccess) { fprintf(stderr, "kernel_launch: hipFuncSetAttribute failed\n"); grid = -1; return; }
        if (hipOccupancyMaxActiveBlocksPerMultiprocessor(&per_cu, (const void*)hybrid_fwd, 512, LDS_BYTES) != hipSuccess || per_cu < 1) { fprintf(stderr, "kernel_launch: occupancy query says %d\n", per_cu); }
        (void)hipGetLastError();
        grid = 256;
        if (cus < 256) fprintf(stderr, "kernel_launch: %d CUs < 256: the grid cannot be co-resident\n", cus);
    }
    if (grid < 0) return;
    if (hipMemsetAsync((char*)d_ws + WS_CTL, 0, CTL_ZERO_BYTES, stream) != hipSuccess) return;
    Args a{};
    for (int i = 0; i < 21; ++i) a.in[i] = (const float*)d_in[i];
    a.out = (float*)d_out; a.ws = (unsigned char*)d_ws; a.pad = 0;
#if defined(DEV_PLAN)
    static const int plan[] = { DEV_PLAN };
    int li = 0;
    for (int p : plan) { a.ph_lo = p; a.ph_hi = p + 1; a.li = li++; hipLaunchKernelGGL(hybrid_fwd, dim3(grid), dim3(512), LDS_BYTES, stream, a); }
#else
    a.ph_lo = 0; a.ph_hi = 20; a.li = 0;
    hipLaunchKernelGGL(hybrid_fwd, dim3(grid), dim3(512), LDS_BYTES, stream, a);
#endif
}
```

```cpp
#include <hip/hip_runtime.h>
#include <cstdio>
#include <cstdint>
namespace pg8 {
#define PG8_LAS __attribute__((address_space(3)))
typedef unsigned short bf16_t;
typedef short bf16x8 __attribute__((ext_vector_type(8)));
typedef float f32x4 __attribute__((ext_vector_type(4)));
typedef unsigned u32x4 __attribute__((ext_vector_type(4)));
constexpr int BM = 256, BK = 64, HALF = 128, HTB = HALF * BK * 2  , STAGE_BYTES = 8 * HTB, NXCD = 8, WGM = 8;

__host__ __device__ __forceinline__ int lds_byte(int r, int c) { const int st = (r >> 4) * 2 + (c >> 5), rr = r & 15, cc = c & 31, ob = rr * 64 + cc * 2; return st * 1024 + (ob ^ (((ob >> 9) & 1) << 5)); }
__host__ __device__ __forceinline__ void stage_rc(int b, int& R, int& C) { const int st = b / 1024, sb = b % 1024, swz = sb ^ (((sb >> 9) & 1) << 5); R = (st >> 1) * 16 + swz / 64; C = (st & 1) * 32 + (swz % 64) / 2; }
__host__ __device__ __forceinline__ int perm32(int rho) { const int n = rho >> 4, i = rho & 15; return 8 * (i >> 2) + 4 * n + (i & 3); }

struct Unit { int pm, pn, ord; };
struct Gemm { const bf16_t* A; const bf16_t* Bt; int M, N, K; };

struct StaticOrder {
    int nM, nN, nwg, G, c;
    __host__ __device__ void init(int M, int N, int G_, int c_) { nM = M / BM; nN = N / BM; nwg = nM * nN; G = G_; c = c_; }
    __host__ __device__ bool next(int i, Unit& u) const {
        const long L = (long)i * G + c; if (L >= nwg) return false;
        int wgid = (int)L; { const int q = nwg / NXCD, r = nwg % NXCD, xcd = wgid % NXCD, off = wgid / NXCD; wgid = (xcd < r ? xcd * (q + 1) : r * (q + 1) + (xcd - r) * q) + off; }
        const int nig = WGM * nN, gid = wgid / nig, fm = gid * WGM, gsz = (nM - fm) < WGM ? (nM - fm) : WGM;
        u.pm = fm + ((wgid % nig) % gsz); u.pn = (wgid % nig) / gsz; u.ord = i; return true;
    }
    __device__ __forceinline__ void a_ready(const Unit&) const {}
    __device__ __forceinline__ void done(const Unit&) const {}
};
__device__ __forceinline__ unsigned cvt_pk_bf16(float lo, float hi) { unsigned r; asm volatile("v_cvt_pk_bf16_f32 %0, %1, %2" : "=v"(r) : "v"(lo), "v"(hi)); return r; }
typedef float f32x2 __attribute__((ext_vector_type(2)));
template <class Epi, class Sched, bool ALIGN_EPI = false, bool SP2 = false>
__device__ __forceinline__ void gemm_phase(PG8_LAS unsigned char* lds, const Gemm g, const Sched& S, const Epi& E) {
    const int tid = threadIdx.x, wid = __builtin_amdgcn_readfirstlane(tid >> 6), lane = tid & 63, wr = wid >> 2, wc = wid & 3, fr = lane & 15, fq = lane >> 4;
    const int K = g.K, nt = K / BK;
    unsigned voffA[2], voffB[2];
#pragma unroll
    for (int i = 0; i < 2; ++i) { int R, C; stage_rc(tid * 16 + i * 8192, R, C); const int Rb = Epi::PERM ? ((R & ~31) + perm32(R & 31)) : R;
        voffA[i] = (unsigned)(R * K + C) * 2u; voffB[i] = (unsigned)(Rb * K + C) * 2u; }
    const size_t kstep = (size_t)(BK * 2);
    const size_t hstep = (size_t)HALF * K * 2;
    const size_t tstep = 2 * hstep;
    const unsigned ldsw = (unsigned)wid * 1024u;
    const int aoff = lds_byte(wr * 64 + fr, fq * 8), boff = lds_byte(wc * 32 + fr, fq * 8);
#define PG8_SA(b, h) (((b) * 2 + (h)) * HTB)
#define PG8_SB(b, h) ((4 + (b) * 2 + (h)) * HTB)
#define PG8_STAGE(bufoff, gbase, voff) do { _Pragma("unroll") for (int _i = 0; _i < 2; ++_i) \
        __builtin_amdgcn_global_load_lds((const unsigned*)((const char*)(gbase) + (voff)[_i]), (PG8_LAS unsigned*)(lds + (bufoff) + ldsw + _i * 8192), 16, 0, 0); } while (0)
#define PG8_LDA(dst, b, h) do { _Pragma("unroll") for (int m = 0; m < 4; ++m) _Pragma("unroll") for (int k = 0; k < 2; ++k) dst[m][k] = *(const PG8_LAS bf16x8*)(lds + PG8_SA(b, h) + aoff + m * 2048 + k * 1024); } while (0)
#define PG8_LDB(dst, b, h) do { _Pragma("unroll") for (int n = 0; n < 2; ++n) _Pragma("unroll") for (int k = 0; k < 2; ++k) dst[n][k] = *(const PG8_LAS bf16x8*)(lds + PG8_SB(b, h) + boff + n * 2048 + k * 1024); } while (0)
#define PG8_MMA(ai, bj, At, Bt) do { __builtin_amdgcn_s_setprio(1); _Pragma("unroll") for (int m = 0; m < 4; ++m) _Pragma("unroll") for (int n = 0; n < 2; ++n) _Pragma("unroll") for (int k = 0; k < 2; ++k) \
        acc[ai][bj][m][n] = __builtin_amdgcn_mfma_f32_16x16x32_bf16(Bt[n][k], At[m][k], acc[ai][bj][m][n], 0, 0, 0); __builtin_amdgcn_s_setprio(0); } while (0)
#define PG8_WAIT_V(n) asm volatile("s_waitcnt vmcnt(" #n ")" ::: "memory")
#define PG8_WAIT_L(n) asm volatile("s_waitcnt lgkmcnt(" #n ")" ::: "memory")
#define PG8_BAR __builtin_amdgcn_s_barrier()
#define PG8_SCHED __builtin_amdgcn_sched_barrier(0)
    Unit cur, nxt; int ui = 0;
    if (!S.next(0, cur)) return;
    f32x4 acc[2][2][4][2];
#pragma unroll
    for (int a = 0; a < 2; ++a)
#pragma unroll
        for (int b = 0; b < 2; ++b)
#pragma unroll
            for (int m = 0; m < 4; ++m)
#pragma unroll
                for (int n = 0; n < 2; ++n) acc[a][b][m][n] = (f32x4){0.f, 0.f, 0.f, 0.f};
    bf16x8 At[4][2], B0[2][2], B1[2][2];
    const char* cA = (const char*)g.A + (size_t)cur.pm * tstep; const char* cB = (const char*)g.Bt + (size_t)cur.pn * tstep;
    S.a_ready(cur);
    if constexpr (SP2) {
        PG8_STAGE(PG8_SB(0, 0), cB, voffB); PG8_STAGE(PG8_SB(0, 1), cB + hstep, voffB); PG8_STAGE(PG8_SA(0, 0), cA, voffA); PG8_STAGE(PG8_SA(0, 1), cA + hstep, voffA);
        if (wr == 1) PG8_BAR;
        PG8_WAIT_V(2); PG8_BAR;
        PG8_STAGE(PG8_SB(1, 0), cB + kstep, voffB); PG8_STAGE(PG8_SA(1, 0), cA + kstep, voffA); PG8_STAGE(PG8_SB(1, 1), cB + hstep + kstep, voffB);
        PG8_WAIT_V(6); PG8_BAR;
    } else {
        PG8_STAGE(PG8_SB(0, 0), cB, voffB); PG8_STAGE(PG8_SA(0, 0), cA, voffA); PG8_STAGE(PG8_SB(0, 1), cB + hstep, voffB); PG8_STAGE(PG8_SA(0, 1), cA + hstep, voffA);
        if (wr == 1) PG8_BAR;
        PG8_WAIT_V(4); PG8_BAR;
        PG8_STAGE(PG8_SB(1, 0), cB + kstep, voffB); PG8_STAGE(PG8_SA(1, 0), cA + kstep, voffA); PG8_STAGE(PG8_SB(1, 1), cB + hstep + kstep, voffB);
        PG8_WAIT_V(6); PG8_BAR;
    }
    for (;;) {
        const bool has_next = S.next(ui + 1, nxt);
        const char* nA = has_next ? (const char*)g.A + (size_t)nxt.pm * tstep : cA; const char* nB = has_next ? (const char*)g.Bt + (size_t)nxt.pn * tstep : cB;
        for (int t = 0; t < nt; t += 2) {
            const bool last = (t == nt - 2);
            const char* a1 = cA + (size_t)(t + 1) * kstep;
            const char* a2 = last ? nA : cA + (size_t)(t + 2) * kstep; const char* b2 = last ? nB : cB + (size_t)(t + 2) * kstep;
            const char* a3 = a2 + kstep; const char* b3 = b2 + kstep;
            if (last && has_next) S.a_ready(nxt);
            if constexpr (SP2) {
            PG8_LDB(B0, 0, 0); PG8_LDB(B1, 0, 1); PG8_SCHED; PG8_LDA(At, 0, 0); PG8_STAGE(PG8_SA(1, 1), a1 + hstep, voffA);
            PG8_WAIT_V(8); PG8_WAIT_L(0); PG8_BAR; PG8_MMA(0, 0, At, B0); PG8_MMA(0, 1, At, B1); PG8_BAR; PG8_SCHED;
            PG8_LDA(At, 0, 1); PG8_STAGE(PG8_SB(0, 0), b2, voffB); PG8_STAGE(PG8_SB(0, 1), b2 + hstep, voffB); PG8_STAGE(PG8_SA(0, 0), a2, voffA);
            PG8_WAIT_V(8); PG8_WAIT_L(0); PG8_BAR; PG8_MMA(1, 0, At, B0); PG8_MMA(1, 1, At, B1); PG8_BAR; PG8_SCHED;
            PG8_LDB(B0, 1, 0); PG8_LDB(B1, 1, 1); PG8_SCHED; PG8_LDA(At, 1, 0); PG8_STAGE(PG8_SA(0, 1), a2 + hstep, voffA);
            PG8_WAIT_V(8); PG8_WAIT_L(0); PG8_BAR; PG8_MMA(0, 0, At, B0); PG8_MMA(0, 1, At, B1); PG8_BAR; PG8_SCHED;
            PG8_LDA(At, 1, 1); PG8_STAGE(PG8_SB(1, 0), b3, voffB); PG8_STAGE(PG8_SB(1, 1), b3 + hstep, voffB); PG8_STAGE(PG8_SA(1, 0), a3, voffA);
            PG8_WAIT_V(8); PG8_WAIT_L(0); PG8_BAR; PG8_MMA(1, 0, At, B0); PG8_MMA(1, 1, At, B1); PG8_BAR; PG8_SCHED;
            } else {
            PG8_LDB(B0, 0, 0); PG8_SCHED; PG8_LDA(At, 0, 0); PG8_STAGE(PG8_SA(1, 1), a1 + hstep, voffA);
            PG8_WAIT_L(8); PG8_BAR; PG8_WAIT_L(0); PG8_MMA(0, 0, At, B0); PG8_BAR; PG8_SCHED;
            PG8_LDB(B1, 0, 1); PG8_STAGE(PG8_SB(0, 0), b2, voffB);
            PG8_BAR; PG8_WAIT_L(0); PG8_MMA(0, 1, At, B1); PG8_BAR;
            PG8_LDA(At, 0, 1); PG8_STAGE(PG8_SA(0, 0), a2, voffA);
            PG8_BAR; PG8_WAIT_L(0); PG8_MMA(1, 0, At, B0); PG8_BAR; PG8_SCHED;
            PG8_STAGE(PG8_SB(0, 1), b2 + hstep, voffB);
            PG8_WAIT_V(6); PG8_BAR; PG8_MMA(1, 1, At, B1); PG8_BAR;
            PG8_LDB(B0, 1, 0); PG8_SCHED; PG8_LDA(At, 1, 0); PG8_STAGE(PG8_SA(0, 1), a2 + hstep, voffA);
            PG8_WAIT_L(8); PG8_BAR; PG8_WAIT_L(0); PG8_MMA(0, 0, At, B0); PG8_BAR; PG8_SCHED;
            PG8_LDB(B1, 1, 1); PG8_STAGE(PG8_SB(1, 0), b3, voffB);
            PG8_BAR; PG8_WAIT_L(0); PG8_MMA(0, 1, At, B1); PG8_BAR;
            PG8_LDA(At, 1, 1); PG8_STAGE(PG8_SA(1, 0), a3, voffA);
            PG8_BAR; PG8_WAIT_L(0); PG8_MMA(1, 0, At, B0); PG8_BAR; PG8_SCHED;
            PG8_STAGE(PG8_SB(1, 1), b3 + hstep, voffB);
            PG8_WAIT_V(6); PG8_BAR; PG8_MMA(1, 1, At, B1); PG8_BAR;
            }
        }
        if constexpr (ALIGN_EPI) { if (wr == 0) PG8_BAR; }
        if constexpr (!Epi::AFTER_DRAIN) { E(acc, cur, wr, wc, fr, fq); S.done(cur); }
        if (!has_next) break;
#pragma unroll
        for (int a = 0; a < 2; ++a)
#pragma unroll
            for (int b = 0; b < 2; ++b)
#pragma unroll
                for (int m = 0; m < 4; ++m)
#pragma unroll
                    for (int n = 0; n < 2; ++n) acc[a][b][m][n] = (f32x4){0.f, 0.f, 0.f, 0.f};
        cur = nxt; cA = nA; cB = nB; ++ui;
        if constexpr (ALIGN_EPI) { if (wr == 1) PG8_BAR; }
    }
    PG8_WAIT_V(0);
    if constexpr (!ALIGN_EPI) { if (wr == 0) PG8_BAR; }
    PG8_BAR;
    if constexpr (Epi::AFTER_DRAIN) { E.fused(acc, cur, wr, wc, fr, fq, lds, wid, lane); S.done(cur); }
#undef PG8_SA
#undef PG8_SB
#undef PG8_STAGE
#undef PG8_LDA
#undef PG8_LDB
#undef PG8_MMA
#undef PG8_WAIT_V
#undef PG8_WAIT_L
#undef PG8_BAR
#undef PG8_SCHED
}
}
namespace pg8 {
template <class Epi, class Sched>
__device__ __forceinline__ void gemm_phase_g(PG8_LAS unsigned char* lds, const Gemm g, const Sched& S, const Epi& E, const PG8_LAS int* ridx) {
    const int tid = threadIdx.x, wid = __builtin_amdgcn_readfirstlane(tid >> 6), lane = tid & 63, wr = wid >> 2, wc = wid & 3, fr = lane & 15, fq = lane >> 4;
    const int K = g.K, nt = K / BK;
    int RA[2], CA[2]; unsigned voffB[2];
#pragma unroll
    for (int i = 0; i < 2; ++i) { int R, C; stage_rc(tid * 16 + i * 8192, R, C); const int Rb = Epi::PERM ? ((R & ~31) + perm32(R & 31)) : R;
        RA[i] = R; CA[i] = C * 2; voffB[i] = (unsigned)(Rb * K + C) * 2u; }
    const size_t kstep = (size_t)(BK * 2);
    const size_t hstep = (size_t)HALF * K * 2;
    const size_t tstep = 2 * hstep;
    const unsigned ldsw = (unsigned)wid * 1024u;
    const int aoff = lds_byte(wr * 64 + fr, fq * 8), boff = lds_byte(wc * 32 + fr, fq * 8);
#define PG8_SA(b, h) (((b) * 2 + (h)) * HTB)
#define PG8_SB(b, h) ((4 + (b) * 2 + (h)) * HTB)
#define PG8_STAGE(bufoff, gbase, voff) do { _Pragma("unroll") for (int _i = 0; _i < 2; ++_i) \
        __builtin_amdgcn_global_load_lds((const unsigned*)((const char*)(gbase) + (voff)[_i]), (PG8_LAS unsigned*)(lds + (bufoff) + ldsw + _i * 8192), 16, 0, 0); } while (0)
#define PG8_LDA(dst, b, h) do { _Pragma("unroll") for (int m = 0; m < 4; ++m) _Pragma("unroll") for (int k = 0; k < 2; ++k) dst[m][k] = *(const PG8_LAS bf16x8*)(lds + PG8_SA(b, h) + aoff + m * 2048 + k * 1024); } while (0)
#define PG8_LDB(dst, b, h) do { _Pragma("unroll") for (int n = 0; n < 2; ++n) _Pragma("unroll") for (int k = 0; k < 2; ++k) dst[n][k] = *(const PG8_LAS bf16x8*)(lds + PG8_SB(b, h) + boff + n * 2048 + k * 1024); } while (0)
#define PG8_MMA(ai, bj, At, Bt) do { __builtin_amdgcn_s_setprio(1); _Pragma("unroll") for (int m = 0; m < 4; ++m) _Pragma("unroll") for (int n = 0; n < 2; ++n) _Pragma("unroll") for (int k = 0; k < 2; ++k) \
        acc[ai][bj][m][n] = __builtin_amdgcn_mfma_f32_16x16x32_bf16(Bt[n][k], At[m][k], acc[ai][bj][m][n], 0, 0, 0); __builtin_amdgcn_s_setprio(0); } while (0)
#define PG8_WAIT_V(n) asm volatile("s_waitcnt vmcnt(" #n ")" ::: "memory")
#define PG8_WAIT_L(n) asm volatile("s_waitcnt lgkmcnt(" #n ")" ::: "memory")
#define PG8_BAR __builtin_amdgcn_s_barrier()
#define PG8_SCHED __builtin_amdgcn_sched_barrier(0)
#define PG8_GOFF(dst, ui_) do { _Pragma("unroll") for (int h_ = 0; h_ < 2; ++h_) _Pragma("unroll") for (int i_ = 0; i_ < 2; ++i_) \
        dst[h_][i_] = (unsigned)ridx[(ui_) * 256 + h_ * HALF + RA[i_]] * (unsigned)(K * 2) + (unsigned)CA[i_]; } while (0)
    Unit cur, nxt; int ui = 0, pend = -1;
    if (!S.next(0, cur)) return;
    f32x4 acc[2][2][4][2];
#pragma unroll
    for (int a = 0; a < 2; ++a)
#pragma unroll
        for (int b = 0; b < 2; ++b)
#pragma unroll
            for (int m = 0; m < 4; ++m)
#pragma unroll
                for (int n = 0; n < 2; ++n) acc[a][b][m][n] = (f32x4){0.f, 0.f, 0.f, 0.f};
    bf16x8 At[4][2], B0[2][2], B1[2][2];
    const char* gA = (const char*)g.A; const char* cB = (const char*)g.Bt + (size_t)cur.pn * tstep;
    unsigned vC[2][2], vN[2][2];
    PG8_GOFF(vC, 0);
    S.a_ready(cur);
    PG8_STAGE(PG8_SB(0, 0), cB, voffB); PG8_STAGE(PG8_SB(0, 1), cB + hstep, voffB); PG8_STAGE(PG8_SA(0, 0), gA, vC[0]); PG8_STAGE(PG8_SA(0, 1), gA, vC[1]);
    if (wr == 1) PG8_BAR;
    PG8_WAIT_V(2); PG8_BAR;
    PG8_STAGE(PG8_SB(1, 0), cB + kstep, voffB); PG8_STAGE(PG8_SA(1, 0), gA + kstep, vC[0]); PG8_STAGE(PG8_SB(1, 1), cB + hstep + kstep, voffB);
    PG8_WAIT_V(6); PG8_BAR;
    for (;;) {
        const bool has_next = S.next(ui + 1, nxt);
        const char* nB = has_next ? (const char*)g.Bt + (size_t)nxt.pn * tstep : cB;
        if (has_next) { PG8_GOFF(vN, ui + 1); } else {
#pragma unroll
            for (int h_ = 0; h_ < 2; ++h_)
#pragma unroll
                for (int i_ = 0; i_ < 2; ++i_) vN[h_][i_] = vC[h_][i_]; }
        for (int t = 0; t < nt; t += 2) {
            const bool last = (t == nt - 2);
            const char* a1 = gA + (size_t)(t + 1) * kstep;
            const char* a2 = last ? gA : gA + (size_t)(t + 2) * kstep; const char* b2 = last ? nB : cB + (size_t)(t + 2) * kstep;
            const char* a3 = a2 + kstep; const char* b3 = b2 + kstep;
            unsigned v2[2][2];
#pragma unroll
            for (int h_ = 0; h_ < 2; ++h_)
#pragma unroll
                for (int i_ = 0; i_ < 2; ++i_) v2[h_][i_] = last ? vN[h_][i_] : vC[h_][i_];
            if (last && has_next) S.a_ready(nxt);
            PG8_LDB(B0, 0, 0); PG8_LDB(B1, 0, 1); PG8_SCHED; PG8_LDA(At, 0, 0); PG8_STAGE(PG8_SA(1, 1), a1, vC[1]);
            PG8_WAIT_V(8); PG8_WAIT_L(0); PG8_BAR; PG8_MMA(0, 0, At, B0); PG8_MMA(0, 1, At, B1); PG8_BAR; PG8_SCHED;
            PG8_LDA(At, 0, 1); PG8_STAGE(PG8_SB(0, 0), b2, voffB); PG8_STAGE(PG8_SB(0, 1), b2 + hstep, voffB); PG8_STAGE(PG8_SA(0, 0), a2, v2[0]);
            PG8_WAIT_V(8); PG8_WAIT_L(0); PG8_BAR; PG8_MMA(1, 0, At, B0); PG8_MMA(1, 1, At, B1); PG8_BAR; PG8_SCHED;
            PG8_LDB(B0, 1, 0); PG8_LDB(B1, 1, 1); PG8_SCHED; PG8_LDA(At, 1, 0); PG8_STAGE(PG8_SA(0, 1), a2, v2[1]);
            PG8_WAIT_V(8); PG8_WAIT_L(0); PG8_BAR; PG8_MMA(0, 0, At, B0); PG8_MMA(0, 1, At, B1); PG8_BAR; PG8_SCHED;
            PG8_LDA(At, 1, 1); PG8_STAGE(PG8_SB(1, 0), b3, voffB); PG8_STAGE(PG8_SB(1, 1), b3 + hstep, voffB); PG8_STAGE(PG8_SA(1, 0), a3, v2[0]);
            PG8_WAIT_V(8); PG8_WAIT_L(0); PG8_BAR; PG8_MMA(1, 0, At, B0); PG8_MMA(1, 1, At, B1); PG8_BAR; PG8_SCHED;
        }
        if (wr == 0) PG8_BAR;
        if (pend >= 0) S.signal(pend);
        E(acc, cur, wr, wc, fr, fq); S.done(cur); pend = cur.pm;
        if (!has_next) break;
#pragma unroll
        for (int a = 0; a < 2; ++a)
#pragma unroll
            for (int b = 0; b < 2; ++b)
#pragma unroll
                for (int m = 0; m < 4; ++m)
#pragma unroll
                    for (int n = 0; n < 2; ++n) acc[a][b][m][n] = (f32x4){0.f, 0.f, 0.f, 0.f};
        cur = nxt; cB = nB; ++ui;
#pragma unroll
        for (int h_ = 0; h_ < 2; ++h_)
#pragma unroll
            for (int i_ = 0; i_ < 2; ++i_) vC[h_][i_] = vN[h_][i_];
        if (wr == 1) PG8_BAR;
    }
    PG8_WAIT_V(0);
    PG8_BAR;
    if (pend >= 0) S.signal(pend);
#undef PG8_GOFF
#undef PG8_SA
#undef PG8_SB
#undef PG8_STAGE
#undef PG8_LDA
#undef PG8_LDB
#undef PG8_MMA
#undef PG8_WAIT_V
#undef PG8_WAIT_L
#undef PG8_BAR
#undef PG8_SCHED
}
}
constexpr int DM = 1024, NBATCH = 2, SEQ = 16384, NMETA = 16, LQ = SEQ + NMETA, LP = 16640, MP = NBATCH * LP;
constexpr int NBLK16 = LQ / 16;
constexpr int FH = 16, FD = 64;
constexpr int HH = 8, HK = 128, HV = 128;
constexpr int NEXP = 32, EPG = 8, DEXP = 512;
constexpr int XPAD_TILES = 290, XPAD_ROWS = XPAD_TILES * 256;
constexpr float EPS = 1e-6f, LOG2E = 1.4426950408889634f;
constexpr float C2 = 0.125f * LOG2E;
constexpr float SKIP_T = 150.f;

constexpr size_t MiB = 1u << 20;
constexpr size_t WS_CTL = 0, CTL_ZERO_BYTES = 1 * MiB;
constexpr size_t WS_WSM = 1 * MiB;
constexpr size_t WS_WQKV = 2 * MiB, WS_WFO = 8 * MiB, WS_WHI = 10 * MiB, WS_WHO = 18 * MiB, WS_WUP = 20 * MiB, WS_WDN = 148 * MiB;
constexpr size_t WS_H = 212 * MiB;
constexpr size_t WS_XN = 342 * MiB;
constexpr size_t WS_Q = 407 * MiB, WS_K = 472 * MiB, WS_V = 537 * MiB;
constexpr size_t WS_LFT = 602 * MiB, WS_CC = 605 * MiB;
constexpr size_t WS_OG = 608 * MiB;
constexpr size_t WS_TOK = 673 * MiB;
constexpr size_t WS_SROW = WS_TOK + 1280 * 1024;
constexpr size_t WS_RSTD = WS_TOK + 1664 * 1024;
constexpr size_t WS_RS = WS_LFT;
constexpr size_t WS_RB = 675 * MiB;
constexpr size_t WS_XPAD = WS_RB, WS_ACT = WS_RB + 145 * MiB;
constexpr size_t WS_LOGF = WS_RB, WS_SLOC = WS_RB + 130 * MiB, WS_ST = WS_RB + 258 * MiB, WS_BE = WS_RB + 323 * MiB;
constexpr size_t WS_END = 1000 * MiB;
static_assert(WS_XPAD + (size_t)XPAD_ROWS * 2048 <= WS_ACT && WS_ACT + (size_t)XPAD_ROWS * 1024 <= WS_END, "moe map");
static_assert(WS_LOGF + (size_t)MP * 4096 <= WS_SLOC && WS_SLOC + (size_t)2048 * 65536 <= WS_ST && WS_ST + (size_t)2064 * 32768 <= WS_BE && WS_BE + (size_t)2048 * 512 <= WS_END, "hgrn map");
static_assert((size_t)MP * 32 <= 1280 * 1024 && WS_SROW + (size_t)XPAD_ROWS * 4 <= WS_RSTD && WS_RSTD + (size_t)MP * 4 <= WS_RB && (size_t)XPAD_ROWS * 4 <= 2 * MiB, "tok map");
static_assert(WS_H + (size_t)MP * 4096 <= WS_XN && WS_XN + (size_t)MP * 2048 <= WS_Q && WS_V + (size_t)MP * 2048 <= WS_LFT && WS_OG + (size_t)MP * 2048 <= WS_TOK && WS_TOK + (size_t)MP * 32 <= WS_RB, "ws map");
constexpr int CW_BAR = 4096;
constexpr int CW_XMAP = 212992;
constexpr int CW_DEP = 196608;
constexpr int CW_CNT = 131072;
constexpr int RING_BYTES = 131072;
constexpr int MISC_OFF = RING_BYTES;
constexpr int LDS_BYTES = 147456;

#define GAS __attribute__((address_space(1)))
#define LAS __attribute__((address_space(3)))
typedef unsigned short bf16;
typedef unsigned v4u __attribute__((ext_vector_type(4)));
typedef unsigned v2u __attribute__((ext_vector_type(2)));
typedef float f32x4 __attribute__((ext_vector_type(4)));
typedef float f32x16 __attribute__((ext_vector_type(16)));
typedef short bf16x8 __attribute__((ext_vector_type(8)));
typedef short bf16x4 __attribute__((ext_vector_type(4)));
typedef GAS unsigned gu32;
#define RLX_AGENT __ATOMIC_RELAXED, __HIP_MEMORY_SCOPE_AGENT
__device__ __forceinline__ unsigned f2bf(float f) { unsigned u = __builtin_bit_cast(unsigned, f); return (u + 0x7fffu + ((u >> 16) & 1u)) >> 16; }
__device__ __forceinline__ float bf2f(unsigned h) { return __builtin_bit_cast(float, h << 16); }
typedef float f32x2_t __attribute__((ext_vector_type(2))); typedef __bf16 bf16x2_t __attribute__((ext_vector_type(2)));
__device__ __forceinline__ unsigned pk2(float lo, float hi) { f32x2_t v = {lo, hi}; bf16x2_t b = __builtin_convertvector(v, bf16x2_t); return __builtin_bit_cast(unsigned, b); }
__device__ __forceinline__ float bflo(unsigned u) { return __builtin_bit_cast(float, u << 16); }
__device__ __forceinline__ float bfhi(unsigned u) { return __builtin_bit_cast(float, u & 0xffff0000u); }
__device__ __forceinline__ float fexp2(float x) { return __builtin_amdgcn_exp2f(x); }
__device__ __forceinline__ float fexp(float x) { return __builtin_amdgcn_exp2f(x * LOG2E); }
__device__ __forceinline__ float frcp(float x) { return __builtin_amdgcn_rcpf(x); }
__device__ __forceinline__ float silu(float x) { return x * frcp(1.f + fexp(-x)); }
#define XB_TMO      128
#define XB_XCNT(j)  (256  + 64 * (j))
#define XB_XSUB(j)  (1280 + 64 * (j))
#define XB_XGEN(j)  (2304 + 64 * (j))
#define XB_TOP      3328
#define XB_TOPGEN   3392
#define XCD_BAR_WORDS 3456
#define XB_SPIN_CAP (1u << 18)

__device__ __forceinline__ unsigned xb_ld(unsigned* p)              { return __hip_atomic_load(p, __ATOMIC_RELAXED, __HIP_MEMORY_SCOPE_AGENT); }
__device__ __forceinline__ unsigned xb_add(unsigned* p, unsigned v) { return __hip_atomic_fetch_add(p, v, __ATOMIC_RELAXED, __HIP_MEMORY_SCOPE_AGENT); }
__device__ __forceinline__ unsigned xb_xcc_id() { return (unsigned)__builtin_amdgcn_s_getreg((3 << 11) | 20) & 0xFu; }
#define XB_SPIN(cond, bar) do { unsigned _sp = 0; while (cond) { __builtin_amdgcn_s_sleep(1); \
    if ((++_sp & 255u) == 0u) { if (xb_ld(&(bar)[XB_TMO])) break; if (_sp > XB_SPIN_CAP) { atomicAdd(&(bar)[XB_TMO], 1u); break; } } } } while (0)

struct XcdBarrier {
    unsigned* bar; unsigned x;
    volatile LAS unsigned* st;
};

__device__ __forceinline__ XcdBarrier xcd_barrier_post(unsigned* bar, volatile LAS unsigned* st) {
    XcdBarrier b; b.bar = bar; b.x = xb_xcc_id(); b.st = st;
    if (threadIdx.x == 0) (void)xb_add(&bar[XB_XCNT(b.x)], 1u);
    return b;
}
__device__ __forceinline__ void xcd_barrier_complete(unsigned* bar, unsigned x, unsigned& nloc, unsigned& nx) {
    const unsigned G = gridDim.x * gridDim.y * gridDim.z;
    unsigned sum, cnt, mine, sp = 0u;
    for (;;) {
        sum = 0u; cnt = 0u; mine = 0u;
#pragma unroll
        for (unsigned j = 0; j < 16; ++j) { const unsigned c = xb_ld(&bar[XB_XCNT(j)]); sum += c; cnt += (c > 0u) ? 1u : 0u; mine = (j == x) ? c : mine; }
        if (sum == G) break;
        __builtin_amdgcn_s_sleep(1);
        if ((++sp & 255u) == 0u) { if (xb_ld(&bar[XB_TMO])) break; if (sp > XB_SPIN_CAP) { atomicAdd(&bar[XB_TMO], 1u); break; } }
    }
    nloc = mine > 0u ? mine : 1u; nx = cnt > 0u ? cnt : 1u;
}

__device__ __forceinline__ void xcd_barrier(const XcdBarrier& b) {
    asm volatile("s_waitcnt vmcnt(0)" ::: "memory");
    __syncthreads();
    if (threadIdx.x == 0) {
        unsigned* bar = b.bar;
        __builtin_amdgcn_s_waitcnt(0);
        unsigned nloc = b.st[0], nx = b.st[1];
        if (nloc == 0u) { xcd_barrier_complete(bar, b.x, nloc, nx); b.st[0] = nloc; b.st[1] = nx; }
        const unsigned old = xb_add(&bar[XB_XSUB(b.x)], 1u);
        const unsigned gen = old / nloc;
        if (old + 1u == (gen + 1u) * nloc) {
            __builtin_amdgcn_fence(__ATOMIC_RELEASE, "agent");
            asm volatile("s_waitcnt vmcnt(0)" ::: "memory");
            const unsigned og = xb_add(&bar[XB_TOP], 1u);
            const unsigned tg = og / nx;
            if (og + 1u == (tg + 1u) * nx) xb_add(&bar[XB_TOPGEN], 1u);
            else XB_SPIN(xb_ld(&bar[XB_TOPGEN]) == tg, bar);
            __builtin_amdgcn_fence(__ATOMIC_ACQUIRE, "agent");
            xb_add(&bar[XB_XGEN(b.x)], 1u);
            asm volatile("s_waitcnt vmcnt(0)" ::: "memory");
        } else {
            XB_SPIN(xb_ld(&bar[XB_XGEN(b.x)]) == gen, bar);
            __builtin_amdgcn_fence(__ATOMIC_ACQUIRE, "agent");
            asm volatile("s_waitcnt vmcnt(0)" ::: "memory");
        }
    }
    __syncthreads();
}
struct Frame {
    LAS unsigned char* lds;
    unsigned char* ws;
    unsigned* ctl;
    int tid, lane, wave, vcu, G;
    const float* in[21]; float* out;
};
enum { I_X = 0, I_META, I_FOX_NORM, I_FOX_WIN, I_FOX_BF, I_FOX_QN, I_FOX_KN, I_FOX_WOUT, I_HG_NORM, I_HG_WIN, I_HG_BF, I_HG_LB, I_HG_ON, I_HG_WOUT,
       I_MOE_NORM, I_MOE_WGRP, I_MOE_BGRP, I_MOE_WRT, I_MOE_BRT, I_MOE_WUP, I_MOE_WDN };

__device__ __forceinline__ float wave_sum(float v) {
#pragma unroll
    for (int o = 1; o < 64; o <<= 1) v += __shfl_xor(v, o);
    return v;
}

struct TrItem { const float* W; bf16* WT; int ldn, K, k0, n0, orow0; const float* gain; };
__device__ __forceinline__ void tr_load(const TrItem& I, int lane, float (&v)[32]) {
#pragma unroll
    for (int i = 0; i < 32; ++i) { const int kk = 2 * i + (lane >> 5); v[i] = I.W[(size_t)(I.k0 + kk) * I.ldn + I.n0 + (lane & 31)] * (I.gain ? I.gain[I.k0 + kk] : 1.f); }
}
__device__ __forceinline__ void tr_store(const TrItem& I, int lane, const float (&v)[32], LAS float* scr) {
#pragma unroll
    for (int i = 0; i < 32; ++i) { const int kk = 2 * i + (lane >> 5); scr[kk * 33 + (lane & 31)] = v[i]; }
    asm volatile("s_waitcnt lgkmcnt(0)" ::: "memory");
    const int c = lane & 7;
#pragma unroll
    for (int j = 0; j < 4; ++j) { const int n = (lane >> 3) + 8 * j; const LAS float* s = scr + (8 * c) * 33 + n;
        v4u o; o.x = pk2(s[0 * 33], s[1 * 33]); o.y = pk2(s[2 * 33], s[3 * 33]); o.z = pk2(s[4 * 33], s[5 * 33]); o.w = pk2(s[6 * 33], s[7 * 33]);
        *(v4u*)(I.WT + (size_t)(I.orow0 + n) * I.K + I.k0 + 8 * c) = o; }
    asm volatile("s_waitcnt lgkmcnt(0)" ::: "memory");
}
__device__ __forceinline__ int perm_qkv(int n0) { const int tile = n0 >> 8, r = n0 & 255, wc = r >> 6, bj = (r >> 5) & 1; return (tile << 8) + 128 * bj + 32 * wc; }
__device__ __forceinline__ int perm_up(int n0) { const int bj = n0 >> 9, rem = n0 & 511, pn = rem >> 7, j = rem & 127; return 256 * pn + 128 * bj + j; }

__device__ __forceinline__ TrItem moe_item(const Frame& F, int r) {
    constexpr int I_UP1 = 16 * 32, I_UP = 64 * I_UP1, I_DN1 = 8 * 32;
    bf16* WUP = (bf16*)(F.ws + WS_WUP); bf16* WDN = (bf16*)(F.ws + WS_WDN);
    if (r < I_UP) { const int e = r / I_UP1, q = r % I_UP1, kb = q / 32, nb = q % 32;
        return TrItem{F.in[I_MOE_WUP] + (size_t)e * DM * DM, WUP + (size_t)e * DM * DM, DM, DM, 64 * kb, 32 * nb, perm_up(32 * nb), F.in[I_MOE_NORM] + (e >> 5) * DM}; }
    r -= I_UP; const int e = r / I_DN1, q = r % I_DN1, kb = q / 32, nb = q % 32;
    return TrItem{F.in[I_MOE_WDN] + (size_t)e * DEXP * DM, WDN + (size_t)e * DM * DEXP, DM, DEXP, 64 * kb, 32 * nb, 32 * nb, nullptr};
}
__device__ __forceinline__ TrItem dense_item(const Frame& F, int r) {
    constexpr int I_QKV = 16 * 96, I_FO = 16 * 32, I_HI = 16 * 128;
    if (r < I_QKV) { const int kb = r / 96, nb = r % 96; return TrItem{F.in[I_FOX_WIN], (bf16*)(F.ws + WS_WQKV), 3 * DM + FH, DM, 64 * kb, 32 * nb, perm_qkv(32 * nb), F.in[I_FOX_NORM]}; } r -= I_QKV;
    if (r < I_FO) { const int kb = r / 32, nb = r % 32; return TrItem{F.in[I_FOX_WOUT], (bf16*)(F.ws + WS_WFO), DM, DM, 64 * kb, 32 * nb, 32 * nb, nullptr}; } r -= I_FO;
    if (r < I_HI) { const int kb = r / 128, nb = r % 128; return TrItem{F.in[I_HG_WIN], (bf16*)(F.ws + WS_WHI), 4 * DM, DM, 64 * kb, 32 * nb, 32 * nb, F.in[I_HG_NORM]}; } r -= I_HI;
    { const int kb = r / 32, nb = r % 32; return TrItem{F.in[I_HG_WOUT], (bf16*)(F.ws + WS_WHO), DM, DM, 64 * kb, 32 * nb, 32 * nb, nullptr}; }
}
#define TR_PIPELINE(ITEM_FN, NITEMS_) do { LAS float* scr = (LAS float*)(F.lds + F.wave * 16384); const int NGW = F.G * 8; int it = F.vcu * 8 + F.wave; \
    if (it < (NITEMS_)) { TrItem cur = ITEM_FN(F, it); float va[32], vb[32]; tr_load(cur, F.lane, va); \
        for (;;) { { const int itn = it + NGW; TrItem nx = cur; __builtin_amdgcn_s_waitcnt(0x0F70); if (itn < (NITEMS_)) { nx = ITEM_FN(F, itn); tr_load(nx, F.lane, vb); } tr_store(cur, F.lane, va, scr); it = itn; cur = nx; if (it >= (NITEMS_)) break; } \
                   { const int itn = it + NGW; TrItem nx = cur; __builtin_amdgcn_s_waitcnt(0x0F70); if (itn < (NITEMS_)) { nx = ITEM_FN(F, itn); tr_load(nx, F.lane, va); } tr_store(cur, F.lane, vb, scr); it = itn; cur = nx; if (it >= (NITEMS_)) break; } } } } while (0)
__device__ __forceinline__ void p0_moe_weights(const Frame& F) { TR_PIPELINE(moe_item, 64 * 16 * 32 + 64 * 8 * 32); }
__device__ __forceinline__ void p0_prologue(const Frame& F) {
    TR_PIPELINE(dense_item, 16 * 96 + 16 * 32 + 16 * 128 + 16 * 32);
    const int gt = F.vcu * 512 + F.tid, NGT = F.G * 512;
    bf16* WSM = (bf16*)(F.ws + WS_WSM);
    for (int i = gt; i < 16 * 1024 + 2 * 48 * 1024; i += NGT) {
        float w; bf16* hi; bf16* lo;
        if (i < 16 * 1024) { const int n = i >> 10, k = i & 1023; w = F.in[I_FOX_WIN][(size_t)k * (3 * DM + FH) + 3 * DM + n]; hi = WSM + i; lo = WSM + 16384 + i; }
        else { const int j = i - 16 * 1024, l = j / (48 * 1024), q = j % (48 * 1024), n = q >> 10, k = q & 1023;
            w = n < 4 ? F.in[I_MOE_WGRP][((size_t)l * DM + k) * 4 + n] : (n < 36 ? F.in[I_MOE_WRT][((size_t)l * DM + k) * 32 + (n - 4)] : 0.f);
            hi = WSM + 32768 + (size_t)l * 98304 + q; lo = hi + 49152; }
        const unsigned h = f2bf(w); *hi = (bf16)h; *lo = (bf16)f2bf(w - bf2f(h));
    }
    for (int i = gt; i < 4 * NBATCH * (LP - LQ) * 128; i += NGT) { const int which = i / (NBATCH * (LP - LQ) * 128), j = i % (NBATCH * (LP - LQ) * 128), b = j / ((LP - LQ) * 128), q = j % ((LP - LQ) * 128);
        v4u* base = (v4u*)(F.ws + (which == 0 ? WS_H : which == 1 ? WS_Q : which == 2 ? WS_K : WS_V));
        base[((size_t)b * LP + LQ) * 128 + q] = (v4u){0u, 0u, 0u, 0u}; }
}

__device__ __forceinline__ void lds_row8g(const LAS float* p, float (&v)[8]) { const f32x4 a = *(const LAS f32x4*)p, c = *(const LAS f32x4*)(p + 4);
    v[0] = a.x; v[1] = a.y; v[2] = a.z; v[3] = a.w; v[4] = c.x; v[5] = c.y; v[6] = c.z; v[7] = c.w; }
template <int MODE> struct TRegs { f32x4 a[4], c[4]; v4u h[4]; v4u u1[4], u2[4]; float w1, w2; };
template <int MODE> struct TTok { v4u ta; v2u tb; };
template <int MODE> __device__ __forceinline__ void t_tok(const Frame& F, int it, TTok<MODE>& T) {
    if (MODE == 2) { const int r = F.lane & 15, b = it / NBLK16, t = (it % NBLK16) * 16 + r; const unsigned* TOK = (const unsigned*)(F.ws + WS_TOK) + ((size_t)b * LP + t) * 8;
        T.ta = *(const v4u*)TOK; T.tb = *(const v2u*)(TOK + 4); }
}
template <int MODE> __device__ __forceinline__ void t_load(const Frame& F, int it, const TTok<MODE>& T, TRegs<MODE>& R) {
    const int r = F.lane & 15, g = F.lane >> 4, w = F.wave, b = it / NBLK16, t = (it % NBLK16) * 16 + r; const size_t row = (size_t)b * LP + t;
    const bf16* H = (const bf16*)(F.ws + WS_H); const bf16* Y = (const bf16*)(F.ws + WS_XPAD);
    const float* src = (t < NMETA ? F.in[I_META] + (size_t)t * DM : F.in[I_X] + ((size_t)b * SEQ + (t - NMETA)) * DM);
    const bf16* y1 = nullptr; const bf16* y2 = nullptr;
    if (MODE == 2) { const unsigned wa = T.ta.y, wb = T.ta.z; R.w1 = __uint_as_float(wa); R.w2 = __uint_as_float(wb); y1 = Y + (size_t)T.tb.x * DM; y2 = Y + (size_t)T.tb.y * DM; }
#pragma unroll
    for (int ks = 0; ks < 4; ++ks) { const int k0 = 128 * w + 32 * ks + 8 * g;
        if (MODE == 0) { R.a[ks] = *(const f32x4*)(src + k0); R.c[ks] = *(const f32x4*)(src + k0 + 4); } else R.h[ks] = *(const v4u*)(H + row * DM + k0);
        if (MODE == 2) { R.u1[ks] = *(const v4u*)(y1 + k0); R.u2[ks] = *(const v4u*)(y2 + k0); } }
}
__device__ __forceinline__ void t_load1_asm(const Frame& F, int it, TRegs<1>& R) {
    const int r = F.lane & 15, g = F.lane >> 4, w = F.wave, b = it / NBLK16, t = (it % NBLK16) * 16 + r; const size_t row = (size_t)b * LP + t;
    const bf16* p = (const bf16*)(F.ws + WS_H) + row * DM + 128 * w + 8 * g;
    asm volatile("global_load_dwordx4 %0, %4, off\n\tglobal_load_dwordx4 %1, %4, off offset:64\n\tglobal_load_dwordx4 %2, %4, off offset:128\n\tglobal_load_dwordx4 %3, %4, off offset:192"
                 : "=&v"(R.h[0]), "=&v"(R.h[1]), "=&v"(R.h[2]), "=&v"(R.h[3]) : "v"(p) : "memory");
}
#define T_WAIT1(R, n) asm volatile("s_waitcnt vmcnt(" #n ")" : "+v"((R).h[0]), "+v"((R).h[1]), "+v"((R).h[2]), "+v"((R).h[3]) :: "memory")
template <int MODE, int NB, int POST, bool FINAL>
__device__ __forceinline__ void t_proc(const Frame& F, int it, int par, TRegs<MODE>& R, const bf16x8 (&wh)[NB > 0 ? NB : 1][4], const bf16x8 (&wl)[NB > 0 ? NB : 1][4], int layer) {
    const LAS float* gnl = (const LAS float*)(F.lds + 57344);
    const LAS float* bia = (const LAS float*)(F.lds + 61440);
    LAS float* ssq = (LAS float*)(F.lds);
    LAS float* lg = (LAS float*)(F.lds + 1024);
    LAS float* lgs = (LAS float*)(F.lds + 1024 + 49152);
    const int r = F.lane & 15, g = F.lane >> 4, w = F.wave;
    bf16* H = (bf16*)(F.ws + WS_H); unsigned* TOK = (unsigned*)(F.ws + WS_TOK);
    const int b = it / NBLK16, t0 = (it % NBLK16) * 16, t = t0 + r; const size_t row = (size_t)b * LP + t;
    float val[4][8]; float ss = 0.f;
#pragma unroll
    for (int ks = 0; ks < 4; ++ks) {
        const int k0 = 128 * w + 32 * ks + 8 * g;
        f32x4 a, c;
        if (MODE == 0) { a = R.a[ks]; c = R.c[ks]; } else { const v4u hh = R.h[ks]; a = (f32x4){bflo(hh.x), bfhi(hh.x), bflo(hh.y), bfhi(hh.y)}; c = (f32x4){bflo(hh.z), bfhi(hh.z), bflo(hh.w), bfhi(hh.w)}; }
        if (MODE == 2) { const v4u u1 = R.u1[ks], u2 = R.u2[ks]; const float w1 = R.w1, w2 = R.w2;
            a.x += w1 * bflo(u1.x) + w2 * bflo(u2.x); a.y += w1 * bfhi(u1.x) + w2 * bfhi(u2.x); a.z += w1 * bflo(u1.y) + w2 * bflo(u2.y); a.w += w1 * bfhi(u1.y) + w2 * bfhi(u2.y);
            c.x += w1 * bflo(u1.z) + w2 * bflo(u2.z); c.y += w1 * bfhi(u1.z) + w2 * bfhi(u2.z); c.z += w1 * bflo(u1.w) + w2 * bflo(u2.w); c.w += w1 * bfhi(u1.w) + w2 * bfhi(u2.w); }
        if (FINAL) { if (t >= NMETA) { float* o = F.out + ((size_t)b * SEQ + (t - NMETA)) * DM + k0; *(f32x4*)o = a; *(f32x4*)(o + 4) = c; } }
        else if (MODE != 1) { v4u hv; hv.x = pk2(a.x, a.y); hv.y = pk2(a.z, a.w); hv.z = pk2(c.x, c.y); hv.w = pk2(c.z, c.w); *(v4u*)(H + row * DM + k0) = hv;
            a = (f32x4){bflo(hv.x), bfhi(hv.x), bflo(hv.y), bfhi(hv.y)}; c = (f32x4){bflo(hv.z), bfhi(hv.z), bflo(hv.w), bfhi(hv.w)}; }
        val[ks][0] = a.x; val[ks][1] = a.y; val[ks][2] = a.z; val[ks][3] = a.w; val[ks][4] = c.x; val[ks][5] = c.y; val[ks][6] = c.z; val[ks][7] = c.w;
        ss += (a.x * a.x + a.y * a.y) + (a.z * a.z + a.w * a.w) + (c.x * c.x + c.y * c.y) + (c.z * c.z + c.w * c.w);
    }
    if (FINAL) return;
    if (NB > 0) {
        f32x4 acc[NB > 0 ? NB : 1];
#pragma unroll
        for (int nb = 0; nb < NB; ++nb) acc[nb] = (f32x4){0.f, 0.f, 0.f, 0.f};
#pragma unroll
        for (int ks = 0; ks < 4; ++ks) {
            float gk[8]; lds_row8g(gnl + 128 * w + 32 * ks + 8 * g, gk);
            v4u hp, lp;
#pragma unroll
            for (int j = 0; j < 4; ++j) { const float x0 = val[ks][2 * j] * gk[2 * j], x1 = val[ks][2 * j + 1] * gk[2 * j + 1]; const unsigned h = pk2(x0, x1);
                hp[j] = h; lp[j] = pk2(x0 - bflo(h), x1 - bfhi(h)); }
            const bf16x8 ah = __builtin_bit_cast(bf16x8, hp), al = __builtin_bit_cast(bf16x8, lp);
#pragma unroll
            for (int nb = 0; nb < NB; ++nb) {
                const bf16x8 bh = wh[nb][ks], bl = wl[nb][ks];
                acc[nb] = __builtin_amdgcn_mfma_f32_16x16x32_bf16(ah, bh, acc[nb], 0, 0, 0);
                acc[nb] = __builtin_amdgcn_mfma_f32_16x16x32_bf16(ah, bl, acc[nb], 0, 0, 0);
                acc[nb] = __builtin_amdgcn_mfma_f32_16x16x32_bf16(al, bh, acc[nb], 0, 0, 0);
            }
        }
#pragma unroll
        for (int nb = 0; nb < NB; ++nb)
#pragma unroll
            for (int q = 0; q < 4; ++q) lg[((par * 8 + w) * 16 + 4 * g + q) * 48 + 16 * nb + r] = acc[nb][q];
    }
    ss += __shfl_xor(ss, 16); ss += __shfl_xor(ss, 32);
    if (g == 0) ssq[par * 128 + w * 16 + r] = ss;
    __syncthreads();
    float tot = 0.f;
#pragma unroll
    for (int ww = 0; ww < 8; ++ww) tot += ssq[par * 128 + ww * 16 + r];
    const float rstd = __builtin_amdgcn_rsqf(tot * (1.f / DM) + EPS);
    if (w == 0 && g == 0) ((float*)(F.ws + WS_RSTD))[row] = rstd;
    if (POST == 1) {
        if (F.tid < 256) { const int rr = F.tid >> 4, n = F.tid & 15; float s = 0.f, tt = 0.f;
#pragma unroll
            for (int ww = 0; ww < 8; ++ww) { s += lg[((par * 8 + ww) * 16 + rr) * 48 + n]; tt += ssq[par * 128 + ww * 16 + rr]; }
            const float x = s * __builtin_amdgcn_rsqf(tt * (1.f / DM) + EPS) + bia[n];
            const float lf = (x >= 0.f) ? -log1pf(__expf(-x)) : x - log1pf(__expf(x));
            ((float*)(F.ws + WS_LFT))[(size_t)(b * FH + n) * LP + t0 + rr] = lf * LOG2E; }
    }
    if (POST == 2) {
        if (w == 0) {
#pragma unroll
            for (int q = 0; q < 12; ++q) { const int idx = F.lane + 64 * q, rr = idx / 48, n = idx % 48; float s = 0.f;
#pragma unroll
                for (int ww = 0; ww < 8; ++ww) s += lg[((par * 8 + ww) * 16 + rr) * 48 + n];
                lgs[par * 768 + idx] = s; }
            asm volatile("s_waitcnt lgkmcnt(0)" ::: "memory");
            __builtin_amdgcn_wave_barrier();
            if (F.lane < 16) {
                const LAS float* L = lgs + par * 768 + r * 48;
                const LAS float* bg = bia; const LAS float* br = bia + 4;
                float gl[4]; int gi = 0; float gm;
#pragma unroll
                for (int j = 0; j < 4; ++j) gl[j] = L[j] * rstd + bg[j];
                gm = gl[0];
#pragma unroll
                for (int j = 1; j < 4; ++j) if (gl[j] > gm) { gm = gl[j]; gi = j; }
                float gsum = 0.f;
#pragma unroll
                for (int j = 0; j < 4; ++j) gsum += __expf(gl[j] - gm);
                const float ggate = 1.f / gsum;
                float v1 = -3.0e38f, v2 = -3.0e38f; int i1 = 0, i2 = 0;
#pragma unroll
                for (int j = 0; j < 8; ++j) { const float e = L[4 + 8 * gi + j] * rstd + br[8 * gi + j];
                    if (e > v1) { v2 = v1; i2 = i1; v1 = e; i1 = j; } else if (e > v2) { v2 = e; i2 = j; } }
                const float ex = __expf(v2 - v1), p1 = 1.f / (1.f + ex);
                const int e1 = 8 * gi + i1, e2 = 8 * gi + i2;
                v4u ta; ta.x = (unsigned)e1 | ((unsigned)e2 << 8); ta.y = __builtin_bit_cast(unsigned, ggate * p1); ta.z = __builtin_bit_cast(unsigned, ggate * ex * p1); ta.w = __builtin_bit_cast(unsigned, rstd);
                *(v4u*)(TOK + row * 8) = ta;
                LAS unsigned* hist = (LAS unsigned*)(F.lds + 61440 + 256);
                __hip_atomic_fetch_add(hist + e1, 1u, __ATOMIC_RELAXED, __HIP_MEMORY_SCOPE_WORKGROUP);
                __hip_atomic_fetch_add(hist + e2, 1u, __ATOMIC_RELAXED, __HIP_MEMORY_SCOPE_WORKGROUP);
            }
        }
    }
}
template <int MODE, int NB, int POST, bool FINAL>
__device__ __forceinline__ void t_phase(const Frame& F, const float* __restrict__ gain, const bf16* __restrict__ wsm_hi, const bf16* __restrict__ wsm_lo, int layer) {
    constexpr int NIT = NBATCH * NBLK16;
    const int r = F.lane & 15, g = F.lane >> 4, w = F.wave;
    bf16x8 wh[NB > 0 ? NB : 1][4], wl[NB > 0 ? NB : 1][4];
    if (POST == 2) { int* SROW = (int*)(F.ws + WS_SROW); for (int i = F.vcu * 512 + F.tid; i < XPAD_ROWS; i += F.G * 512) SROW[i] = 0; }
    if (!FINAL) {
        LAS float* gnl = (LAS float*)(F.lds + 57344); LAS float* bia = (LAS float*)(F.lds + 61440);
        { const float g0 = gain[F.tid], g1 = gain[F.tid + 512]; gnl[F.tid] = g0; gnl[F.tid + 512] = g1; }
        if (POST == 1 && F.tid < 16) bia[F.tid] = F.in[I_FOX_BF][F.tid];
        if (POST == 2 && F.tid < 36) bia[F.tid] = F.tid < 4 ? F.in[I_MOE_BGRP][layer * 4 + F.tid] : F.in[I_MOE_BRT][layer * 32 + F.tid - 4];
        if (POST == 2 && F.tid < NEXP) ((LAS unsigned*)(F.lds + 61440 + 256))[F.tid] = 0u;
#pragma unroll
        for (int nb = 0; nb < NB; ++nb)
#pragma unroll
            for (int ks = 0; ks < 4; ++ks) { const int k0 = 128 * w + 32 * ks + 8 * g;
                wh[nb][ks] = *(const bf16x8*)(wsm_hi + (size_t)(16 * nb + r) * DM + k0); wl[nb][ks] = *(const bf16x8*)(wsm_lo + (size_t)(16 * nb + r) * DM + k0); }
        __syncthreads();
    }
    int it = blockIdx.x;
    if (MODE == 1 && !FINAL) {
        if (it < NIT) {
            TRegs<1> A, B; int par = 0;
            __builtin_amdgcn_s_waitcnt(0x0F70);
            t_load1_asm(F, it, A); if (it + F.G < NIT) t_load1_asm(F, it + F.G, B);
            for (;;) {
                { if (it + F.G < NIT) T_WAIT1(A, 4); else T_WAIT1(A, 0);
                  t_proc<MODE, NB, POST, FINAL>(F, it, par, (TRegs<MODE>&)A, wh, wl, layer); par ^= 1; if (it + 2 * F.G < NIT) t_load1_asm(F, it + 2 * F.G, A); it += F.G; if (it >= NIT) break; }
                { if (it + F.G < NIT) T_WAIT1(B, 4); else T_WAIT1(B, 0);
                  t_proc<MODE, NB, POST, FINAL>(F, it, par, (TRegs<MODE>&)B, wh, wl, layer); par ^= 1; if (it + 2 * F.G < NIT) t_load1_asm(F, it + 2 * F.G, B); it += F.G; if (it >= NIT) break; }
            }
        }
    } else if (it < NIT) {
        TRegs<MODE> A, B; TTok<MODE> T0, T1;
        t_tok<MODE>(F, it, T0); if (it + F.G < NIT) t_tok<MODE>(F, it + F.G, T1);
        t_load<MODE>(F, it, T0, A);
        int par = 0;
        for (;;) {
            { const int itn = it + F.G; __builtin_amdgcn_s_waitcnt(0x0F70); if (itn < NIT) { t_load<MODE>(F, itn, T1, B); if (itn + F.G < NIT) t_tok<MODE>(F, itn + F.G, T0); }
              t_proc<MODE, NB, POST, FINAL>(F, it, par, A, wh, wl, layer); par ^= 1; it = itn; if (it >= NIT) break; }
            { const int itn = it + F.G; __builtin_amdgcn_s_waitcnt(0x0F70); if (itn < NIT) { t_load<MODE>(F, itn, T0, A); if (itn + F.G < NIT) t_tok<MODE>(F, itn + F.G, T1); }
              t_proc<MODE, NB, POST, FINAL>(F, it, par, B, wh, wl, layer); par ^= 1; it = itn; if (it >= NIT) break; }
        }
    }
    __syncthreads();
    if (POST == 2 && F.tid < NEXP) { const unsigned hv = ((LAS unsigned*)(F.lds + 61440 + 256))[F.tid]; if (hv) __hip_atomic_fetch_add(F.ctl + CW_CNT + layer * 2048 + F.tid * 16, hv, RLX_AGENT); }
}
struct EpiQKV {
    static constexpr bool PERM = true, AFTER_DRAIN = false;
    bf16* Q; const float* gq; const float* gk; const LAS float* rstd;
    __device__ __forceinline__ void operator()(const pg8::f32x4 (&acc)[2][2][4][2], const pg8::Unit& u, int wr, int wc, int fr, int fq) const {
        const int type = u.pn >> 2, head = (u.pn & 3) * 4 + wc;
        bf16* dst = Q + (size_t)type * ((WS_K - WS_Q) / 2);
        float gs[2][8];
        if (type < 2) {
#pragma unroll
            for (int bj = 0; bj < 2; ++bj)
#pragma unroll
                for (int j = 0; j < 8; ++j) { const float a = gq[32 * bj + 8 * fq + j] * C2, b = gk[32 * bj + 8 * fq + j]; gs[bj][j] = type == 0 ? a : b; } }
        const int row0 = u.pm * 256 + wr * 64 + fr;
#pragma unroll
        for (int ai = 0; ai < 2; ++ai)
#pragma unroll
            for (int m = 0; m < 4; ++m) {
                const size_t row = (size_t)(row0 + ai * 128 + m * 16);
                float sc = rstd[u.ord * 256 + wr * 64 + fr + ai * 128 + m * 16];
                if (type < 2) { float ss = 0.f;
#pragma unroll
                    for (int bj = 0; bj < 2; ++bj)
#pragma unroll
                        for (int n = 0; n < 2; ++n) { const pg8::f32x4 x = acc[ai][bj][m][n]; ss += (x[0] * x[0] + x[1] * x[1]) + (x[2] * x[2] + x[3] * x[3]); }
                    ss += __shfl_xor(ss, 16); ss += __shfl_xor(ss, 32);
                    sc = sc * __builtin_amdgcn_rsqf(sc * sc * ss * (1.f / FD) + EPS); }
#pragma unroll
                for (int bj = 0; bj < 2; ++bj) {
                    pg8::f32x4 v0 = acc[ai][bj][m][0], v1 = acc[ai][bj][m][1];
                    if (type < 2) { v0[0] *= sc * gs[bj][0]; v0[1] *= sc * gs[bj][1]; v0[2] *= sc * gs[bj][2]; v0[3] *= sc * gs[bj][3];
                                    v1[0] *= sc * gs[bj][4]; v1[1] *= sc * gs[bj][5]; v1[2] *= sc * gs[bj][6]; v1[3] *= sc * gs[bj][7]; }
                    else { v0 *= sc; v1 *= sc; }
                    v4u o; o.x = pk2(v0[0], v0[1]); o.y = pk2(v0[2], v0[3]); o.z = pk2(v1[0], v1[1]); o.w = pk2(v1[2], v1[3]);
                    *(v4u*)(dst + row * DM + head * FD + 32 * bj + 8 * fq) = o;
                }
            }
    }
};
struct EpiResid {
    static constexpr bool PERM = true, AFTER_DRAIN = false;
    bf16* H;
    __device__ __forceinline__ void operator()(const pg8::f32x4 (&acc)[2][2][4][2], const pg8::Unit& u, int wr, int wc, int fr, int fq) const {
        const int row0 = u.pm * 256 + wr * 64 + fr, col0 = u.pn * 256 + 32 * wc + 8 * fq;
#pragma unroll
        for (int ai = 0; ai < 2; ++ai)
#pragma unroll
            for (int m = 0; m < 4; ++m)
#pragma unroll
                for (int bj = 0; bj < 2; ++bj) { bf16* p = H + (size_t)(row0 + ai * 128 + m * 16) * DM + col0 + 128 * bj;
                    const v4u hh = *(const v4u*)p; const pg8::f32x4 x0 = acc[ai][bj][m][0], x1 = acc[ai][bj][m][1];
                    v4u o; o.x = pk2(bflo(hh.x) + x0[0], bfhi(hh.x) + x0[1]); o.y = pk2(bflo(hh.y) + x0[2], bfhi(hh.y) + x0[3]);
                    o.z = pk2(bflo(hh.z) + x1[0], bfhi(hh.z) + x1[1]); o.w = pk2(bflo(hh.w) + x1[2], bfhi(hh.w) + x1[3]);
                    *(v4u*)p = o; }
    }
};
struct EpiResidX {
    static constexpr bool PERM = true, AFTER_DRAIN = false;
    bf16* H; const float* x; const float* meta;
    __device__ __forceinline__ void operator()(const pg8::f32x4 (&acc)[2][2][4][2], const pg8::Unit& u, int wr, int wc, int fr, int fq) const {
        const int row0 = u.pm * 256 + wr * 64 + fr, col0 = u.pn * 256 + 32 * wc + 8 * fq;
#pragma unroll
        for (int ai = 0; ai < 2; ++ai)
#pragma unroll
            for (int m = 0; m < 4; ++m) { const int row = row0 + ai * 128 + m * 16, b = row / LP, t = row - b * LP;
                if (t < LQ) { const float* src = (t < NMETA ? meta + (size_t)t * DM : x + ((size_t)b * SEQ + (t - NMETA)) * DM) + col0;
#pragma unroll
                    for (int bj = 0; bj < 2; ++bj) { bf16* p = H + (size_t)row * DM + col0 + 128 * bj;
                        f32x4 a = *(const f32x4*)(src + 128 * bj), c = *(const f32x4*)(src + 128 * bj + 4);
                        a += acc[ai][bj][m][0]; c += acc[ai][bj][m][1];
                        v4u o; o.x = pk2(a.x, a.y); o.y = pk2(a.z, a.w); o.z = pk2(c.x, c.y); o.w = pk2(c.z, c.w);
                        *(v4u*)p = o; } } }
    }
};
struct EpiUp {
    static constexpr bool PERM = true, AFTER_DRAIN = false;
    bf16* ACT; const LAS float* rs;
    __device__ __forceinline__ void operator()(const pg8::f32x4 (&acc)[2][2][4][2], const pg8::Unit& u, int wr, int wc, int fr, int fq) const {
        const int row0 = u.pm * 256 + wr * 64 + fr, col0 = (u.pn & 3) * 128 + 32 * wc + 8 * fq;
#pragma unroll
        for (int ai = 0; ai < 2; ++ai)
#pragma unroll
            for (int m = 0; m < 4; ++m) {
                const float sc = rs[u.ord * 256 + wr * 64 + fr + ai * 128 + m * 16];
                const pg8::f32x4 a0 = acc[ai][0][m][0] * sc, a1 = acc[ai][0][m][1] * sc, u0 = acc[ai][1][m][0] * sc, u1 = acc[ai][1][m][1] * sc;
                v4u o; o.x = pk2(silu(a0[0]) * u0[0], silu(a0[1]) * u0[1]); o.y = pk2(silu(a0[2]) * u0[2], silu(a0[3]) * u0[3]);
                o.z = pk2(silu(a1[0]) * u1[0], silu(a1[1]) * u1[1]); o.w = pk2(silu(a1[2]) * u1[2], silu(a1[3]) * u1[3]);
                *(v4u*)(ACT + (size_t)(row0 + ai * 128 + m * 16) * DEXP + col0) = o;
            }
    }
};
struct EpiDown {
    static constexpr bool PERM = true, AFTER_DRAIN = false;
    bf16* Y;
    __device__ __forceinline__ void operator()(const pg8::f32x4 (&acc)[2][2][4][2], const pg8::Unit& u, int wr, int wc, int fr, int fq) const {
        const int row0 = u.pm * 256 + wr * 64 + fr, col0 = (u.pn & 3) * 256 + 32 * wc + 8 * fq;
#pragma unroll
        for (int ai = 0; ai < 2; ++ai)
#pragma unroll
            for (int m = 0; m < 4; ++m)
#pragma unroll
                for (int bj = 0; bj < 2; ++bj) { const pg8::f32x4 v0 = acc[ai][bj][m][0], v1 = acc[ai][bj][m][1];
                    v4u o; o.x = pk2(v0[0], v0[1]); o.y = pk2(v0[2], v0[3]); o.z = pk2(v1[0], v1[1]); o.w = pk2(v1[2], v1[3]);
                    *(v4u*)(Y + (size_t)(row0 + ai * 128 + m * 16) * DM + col0 + 128 * bj) = o; }
    }
};
struct EpiHgIn {
    static constexpr bool PERM = true, AFTER_DRAIN = false;
    bf16* QS; float* LOGF; const float* bfv; const float* lbl; const LAS float* rstd;
    __device__ __forceinline__ void operator()(const pg8::f32x4 (&acc)[2][2][4][2], const pg8::Unit& u, int wr, int wc, int fr, int fq) const {
        const int type = u.pn >> 2, row0 = u.pm * 256 + wr * 64 + fr, col0 = (u.pn & 3) * 256 + 32 * wc + 8 * fq;
        float bias[2][8], lb[2][8];
        if (type == 1) {
#pragma unroll
            for (int bj = 0; bj < 2; ++bj)
#pragma unroll
                for (int j = 0; j < 8; ++j) { const int c = col0 + 128 * bj + j; bias[bj][j] = bfv[c]; lb[bj][j] = frcp(1.f + fexp(lbl[c] - lbl[DM + c])); }
        }
        bf16* dst = QS + (size_t)(type == 0 ? 0 : (type == 2 ? 2 : 1)) * ((WS_K - WS_Q) / 2);
#pragma unroll
        for (int ai = 0; ai < 2; ++ai)
#pragma unroll
            for (int m = 0; m < 4; ++m)
#pragma unroll
                for (int bj = 0; bj < 2; ++bj) {
                    const size_t off = (size_t)(row0 + ai * 128 + m * 16) * DM + col0 + 128 * bj;
                    float v[8]; const float sc = rstd[u.ord * 256 + wr * 64 + fr + ai * 128 + m * 16];
#pragma unroll
                    for (int j = 0; j < 4; ++j) { v[j] = acc[ai][bj][m][0][j] * sc; v[4 + j] = acc[ai][bj][m][1][j] * sc; }
                    if (type == 1) {
#pragma unroll
                        for (int j = 0; j < 8; ++j) { const float sg = frcp(1.f + fexp(-(v[j] + bias[bj][j]))); const float f = lb[bj][j] + (1.f - lb[bj][j]) * sg; v[j] = __logf(f); }
                        *(f32x4*)(LOGF + off) = (f32x4){v[0], v[1], v[2], v[3]}; *(f32x4*)(LOGF + off + 4) = (f32x4){v[4], v[5], v[6], v[7]};
                    } else {
                        if (type != 2) {
#pragma unroll
                            for (int j = 0; j < 8; ++j) v[j] = silu(v[j]); }
                        v4u o; o.x = pk2(v[0], v[1]); o.y = pk2(v[2], v[3]); o.z = pk2(v[4], v[5]); o.w = pk2(v[6], v[7]);
                        *(v4u*)(dst + off) = o;
                    }
                }
    }
};

__device__ __forceinline__ void fox_scan(const Frame& F) {
    if (blockIdx.x >= NBATCH * FH) return;
    LAS float* buf = (LAS float*)F.lds;
    LAS float* wt = (LAS float*)(F.lds + 69632);
    const float* src = (const float*)(F.ws + WS_LFT) + (size_t)blockIdx.x * LP; float* dst = (float*)(F.ws + WS_CC) + (size_t)blockIdx.x * LP;
    { float v[33];
#pragma unroll
        for (int j = 0; j < 33; ++j) { const int i = F.tid + 512 * j; v[j] = (i < LQ) ? src[i] : 0.f; }
#pragma unroll
        for (int j = 0; j < 33; ++j) { const int i = F.tid + 512 * j; if (i < LP) buf[i] = v[j]; } }
    __syncthreads();
    constexpr int PER = 33;
    const int s0 = F.tid * PER;
    float part = 0.f;
    for (int j = 0; j < PER; ++j) { const int i = s0 + j; if (i < LP) part += buf[i]; }
    float inc = part;
#pragma unroll
    for (int o = 1; o < 64; o <<= 1) { const float n = __shfl_up(inc, o); if (F.lane >= o) inc += n; }
    if (F.lane == 63) wt[F.wave] = inc;
    __syncthreads();
    float base = inc - part;
    for (int ww = 0; ww < F.wave; ++ww) base += wt[ww];
    float run = base;
    for (int j = 0; j < PER; ++j) { const int i = s0 + j; if (i < LP) { run += buf[i]; buf[i] = run; } }
    __syncthreads();
    for (int i = F.tid; i < LP; i += 512) dst[i] = buf[i];
    __syncthreads();
}

constexpr int AT_SUB = 16640;
constexpr int AT_BUF = 2 * AT_SUB;
constexpr int AT_WS = 2 * AT_BUF;
constexpr int AT_MISC = AT_WS + 2048;
__device__ __forceinline__ int crow(int r, int hi) { return (r & 3) + 8 * (r >> 2) + 4 * hi; }
typedef short v4i16_t __attribute__((ext_vector_type(4)));
__device__ __forceinline__ bf16x4 vtr(const LAS unsigned char* p) { return __builtin_bit_cast(bf16x4, __builtin_amdgcn_ds_read_tr16_b64_v4i16((LAS v4i16_t*)p)); }

__device__ __forceinline__ void attn_tile(const LAS unsigned char* B, int t, int wrow0, int lane, int r32, int hi, float cqb, float cw0, float thr, const bf16x8 (&qr)[4], float& l, f32x16 (&o)[2]) {
    const LAS float* ct = (const LAS float*)(B + 16384);
    if (64 * t <= wrow0 + 31 && cw0 - ct[63] >= thr) {
        f32x16 p0, p1;
#pragma unroll
        for (int rq = 0; rq < 4; ++rq) { const f32x4 c0 = *(const LAS f32x4*)(ct + 8 * rq + 4 * hi), c1 = *(const LAS f32x4*)(ct + 32 + 8 * rq + 4 * hi);
#pragma unroll
            for (int i = 0; i < 4; ++i) { p0[4 * rq + i] = cqb - c0[i]; p1[4 * rq + i] = cqb - c1[i]; } }
#pragma unroll
        for (int d0 = 0; d0 < 4; ++d0) {
            const bf16x8 a0 = *(const LAS bf16x8*)(B + (2 * d0 + hi) * 1024 + r32 * 16), a1 = *(const LAS bf16x8*)(B + (2 * d0 + hi) * 1024 + 512 + r32 * 16);
            p0 = __builtin_amdgcn_mfma_f32_32x32x16_bf16(a0, qr[d0], p0, 0, 0, 0);
            p1 = __builtin_amdgcn_mfma_f32_32x32x16_bf16(a1, qr[d0], p1, 0, 0, 0);
        }
        if (64 * t + 63 > wrow0) {
            const int qpos = wrow0 + r32, kb = 64 * t + 4 * hi;
#pragma unroll
            for (int r = 0; r < 16; ++r) { const int kv = kb + (r & 3) + 8 * (r >> 2); if (kv > qpos) p0[r] = -1.0e30f; if (kv + 32 > qpos) p1[r] = -1.0e30f; }
        }
        float sacc = 0.f;
#pragma unroll
        for (int r = 0; r < 16; ++r) { p0[r] = fexp2(p0[r]); p1[r] = fexp2(p1[r]); sacc += p0[r] + p1[r]; }
        l += sacc;
        bf16x8 pa[4];
#pragma unroll
        for (int s = 0; s < 4; ++s) { const f32x16& P = (s < 2) ? p0 : p1; const int h8 = 8 * (s & 1);
            v4u pk; pk.x = pk2(P[h8 + 0], P[h8 + 1]); pk.y = pk2(P[h8 + 2], P[h8 + 3]); pk.z = pk2(P[h8 + 4], P[h8 + 5]); pk.w = pk2(P[h8 + 6], P[h8 + 7]);
            pa[s] = __builtin_bit_cast(bf16x8, pk); }
        const LAS unsigned char* vp = B + 8192 + ((lane >> 4) & 1) * 32 + (lane & 3) * 8 + (4 * hi + ((lane & 15) >> 2)) * 64;
#pragma unroll
        for (int dq = 0; dq < 2; ++dq)
#pragma unroll
            for (int s = 0; s < 4; ++s) { const bf16x4 lo = vtr(vp + dq * 4096 + s * 1024), hh = vtr(vp + dq * 4096 + s * 1024 + 512);
                const bf16x8 vf = (bf16x8){lo[0], lo[1], lo[2], lo[3], hh[0], hh[1], hh[2], hh[3]};
                o[dq] = __builtin_amdgcn_mfma_f32_32x32x16_bf16(pa[s], vf, o[dq], 0, 0, 0); }
    }
}
__device__ __forceinline__ void attn_unit(const Frame& F, int b, int hd, int qb, float thr, float bq) {
    const int tid = F.tid, lane = F.lane, w = F.wave, r32 = lane & 31, hi = lane >> 5;
    const size_t rowb = (size_t)b * LP; const int q0 = qb * 256;
    const bf16* Qh = (const bf16*)(F.ws + WS_Q) + rowb * DM + hd * FD; const bf16* Kh = (const bf16*)(F.ws + WS_K) + rowb * DM + hd * FD; const bf16* Vh = (const bf16*)(F.ws + WS_V) + rowb * DM + hd * FD;
    bf16* Oh = (bf16*)(F.ws + WS_Q) + rowb * DM + hd * FD;
    const float* Cs = (const float*)(F.ws + WS_CC) + (size_t)(b * FH + hd) * LP;
    LAS unsigned char* L = F.lds; LAS float* wsf = (LAS float*)(L + AT_WS) + w * 64; LAS int* misc = (LAS int*)(L + AT_MISC);
    const int t_hi = (qb == 64) ? 256 : 4 * qb + 3;
    if (tid == 0) misc[0] = t_hi;
    __syncthreads();
    { const float ci0 = Cs[q0]; if (tid <= t_hi) { if (ci0 - Cs[64 * tid + 63] >= thr) __hip_atomic_fetch_min(misc, tid, __ATOMIC_RELAXED, __HIP_MEMORY_SCOPE_WORKGROUP); } }
    __syncthreads();
    const int t_lo = misc[0];
    bf16x8 qr[4];
#pragma unroll
    for (int d0 = 0; d0 < 4; ++d0) qr[d0] = *(const bf16x8*)(Qh + (size_t)(q0 + 32 * w + r32) * DM + 16 * d0 + 8 * hi);
    const int wrow0 = q0 + 32 * w;
    const float cq = Cs[wrow0 + r32], cqb = cq - bq, cw0 = __shfl(cq, 0);
    float l = 0.f; f32x16 o[2];
#pragma unroll
    for (int r = 0; r < 16; ++r) { o[0][r] = 0.f; o[1][r] = 0.f; }
    const int skv = tid >> 3, sc = tid & 7;
    const bf16* ksrc = Kh + (size_t)skv * DM + 8 * sc; const bf16* vsrc = Vh + (size_t)skv * DM + 8 * sc;
    const int kdst = sc * 1024 + skv * 16, vdst = 8192 + (sc >> 2) * 4096 + skv * 64 + (sc & 3) * 16;
#define AT_LOAD(tt) do { k0_ = *(const v4u*)(ksrc + (size_t)(tt) * 64 * DM); v0_ = *(const v4u*)(vsrc + (size_t)(tt) * 64 * DM); k1_ = *(const v4u*)(ksrc + (size_t)((tt) + 1) * 64 * DM); v1_ = *(const v4u*)(vsrc + (size_t)((tt) + 1) * 64 * DM); \
        if (tid < 128) c_ = Cs[64 * (tt) + tid]; } while (0)
#define AT_STORE(bufo) do { LAS unsigned char* Bn_ = L + (bufo) * AT_BUF; *(LAS v4u*)(Bn_ + kdst) = k0_; *(LAS v4u*)(Bn_ + vdst) = v0_; *(LAS v4u*)(Bn_ + AT_SUB + kdst) = k1_; *(LAS v4u*)(Bn_ + AT_SUB + vdst) = v1_; \
        if (tid < 128) *(LAS float*)(Bn_ + (tid >> 6) * AT_SUB + 16384 + 4 * (tid & 63)) = c_; } while (0)
    v4u k0_, v0_, k1_, v1_; float c_ = 0.f;
    const int p_hi = t_hi >> 1, p_lo = t_lo >> 1;
    AT_LOAD(2 * p_hi); AT_STORE(0);
    if (p_hi > p_lo) AT_LOAD(2 * p_hi - 2);
    __syncthreads();
    int cur = 0;
    const bool live = wrow0 < (qb == 64 ? LQ : 0x7fffffff);
    for (int pp = p_hi; pp >= p_lo; --pp) {
        const LAS unsigned char* B = L + cur * AT_BUF;
        if (live) { attn_tile(B + AT_SUB, 2 * pp + 1, wrow0, lane, r32, hi, cqb, cw0, thr, qr, l, o); attn_tile(B, 2 * pp, wrow0, lane, r32, hi, cqb, cw0, thr, qr, l, o); }
        if (pp > p_lo) { AT_STORE(cur ^ 1); if (pp - 1 > p_lo) AT_LOAD(2 * pp - 4); }
        __syncthreads(); cur ^= 1;
    }
#undef AT_LOAD
#undef AT_STORE
    { auto rr = __builtin_amdgcn_permlane32_swap(__float_as_uint(l), __float_as_uint(l), false, false); l = __uint_as_float(rr[0]) + __uint_as_float(rr[1]); }
    if (hi == 0) wsf[32 + r32] = l;
    asm volatile("s_waitcnt lgkmcnt(0)" ::: "memory");
    __builtin_amdgcn_wave_barrier();
#pragma unroll
    for (int rq = 0; rq < 4; ++rq) { const f32x4 lv = *(const LAS f32x4*)(wsf + 32 + 8 * rq + 4 * hi);
#pragma unroll
        for (int i = 0; i < 4; ++i) { const int r = 4 * rq + i; const float rl = frcp(lv[i]); bf16* op = Oh + (size_t)(wrow0 + crow(r, hi)) * DM + r32;
            op[0] = (bf16)f2bf(o[0][r] * rl); op[32] = (bf16)f2bf(o[1][r] * rl); } }
    __syncthreads();
}
__device__ __forceinline__ void attn_phase(const Frame& F) {
    float gq = fabsf(F.in[I_FOX_QN][F.lane]), gk = fabsf(F.in[I_FOX_KN][F.lane]);
#pragma unroll
    for (int o = 1; o < 64; o <<= 1) { gq = fmaxf(gq, __shfl_xor(gq, o)); gk = fmaxf(gk, __shfl_xor(gk, o)); }
    const float bq = 1.01f * C2 * FD * gq * gk, thr = -SKIP_T;
    for (int i = 0;; ++i) {
        const int id = i * F.G + F.vcu; if (id >= 65 * NBATCH * FH) break;
        int bh, qb; if (id < 64 * NBATCH * FH) { bh = id >> 6; qb = 63 - (id & 63); } else { bh = id - 64 * NBATCH * FH; qb = 64; }
        attn_unit(F, bh >> 4, bh & 15, qb, thr, bq);
    }
}
struct MainOrder {
    pg8::StaticOrder S;
    __device__ __forceinline__ void init(int N, int G, int c) { S.init(128 * 256, N, G, c); }
    __device__ __forceinline__ bool next(int i, pg8::Unit& u) const { if (!S.next(i, u)) return false; u.pm += (u.pm >= 64) ? 1 : 0; return true; }
    __device__ __forceinline__ void a_ready(const pg8::Unit&) const {}
    __device__ __forceinline__ void done(const pg8::Unit&) const {}
};
__device__ __forceinline__ int perm_qkv_row(int n) { return (n & ~255) + 128 * ((n >> 5) & 1) + 32 * ((n >> 6) & 3) + (n & 31); }
template <int KIND  >
__device__ __forceinline__ void skinny_gemm(const Frame& F, const bf16* __restrict__ A, const bf16* __restrict__ Bt, int N) {
    const int ntask = 2 * (N / 64), task = (int)blockIdx.x - (KIND == 0 ? 32 : 0);
    if (task < 0 || task >= ntask) return;
    const int b = task & 1, cg = task >> 1, i16 = F.lane & 15, g = F.lane >> 4;
    const size_t row0 = (size_t)b * LP + SEQ;
    const bf16* ap = A + (row0 + i16) * DM + 8 * g;
    const bf16* bp[4];
#pragma unroll
    for (int nb = 0; nb < 4; ++nb) { const int n = 64 * cg + 16 * nb + i16; bp[nb] = Bt + (size_t)(KIND == 0 ? perm_qkv_row(n) : n) * DM + 8 * g; }
    f32x4 acc[4];
#pragma unroll
    for (int nb = 0; nb < 4; ++nb) acc[nb] = (f32x4){0.f, 0.f, 0.f, 0.f};
#pragma unroll
    for (int kk = 0; kk < 4; ++kk) { const int ks = 4 * F.wave + kk; const bf16x8 af = *(const bf16x8*)(ap + 32 * ks);
#pragma unroll
        for (int nb = 0; nb < 4; ++nb) acc[nb] = __builtin_amdgcn_mfma_f32_16x16x32_bf16(af, *(const bf16x8*)(bp[nb] + 32 * ks), acc[nb], 0, 0, 0); }
    { LAS f32x4* red = (LAS f32x4*)F.lds;
#pragma unroll
        for (int nb = 0; nb < 4; ++nb) red[(F.wave * 4 + nb) * 64 + F.lane] = acc[nb];
        __syncthreads();
        if (F.wave == 0) {
#pragma unroll
            for (int nb = 0; nb < 4; ++nb) { f32x4 s = red[nb * 64 + F.lane];
#pragma unroll
                for (int ww = 1; ww < 8; ++ww) s += red[(ww * 4 + nb) * 64 + F.lane];
                acc[nb] = s; } }
        __syncthreads();
        if (F.wave != 0) return; }
    unsigned char* ws = F.ws;
    if (KIND == 0 || KIND == 3) { const float* RSTD = (const float*)(ws + WS_RSTD);
#pragma unroll
        for (int r = 0; r < 4; ++r) { const float sc = RSTD[row0 + 4 * g + r];
#pragma unroll
            for (int nb = 0; nb < 4; ++nb) acc[nb][r] *= sc; } }
    if (KIND == 0) {
        const int type = cg >> 4, head = cg & 15; bf16* dst = (bf16*)(ws + WS_Q) + (size_t)type * ((WS_K - WS_Q) / 2);
#pragma unroll
        for (int r = 0; r < 4; ++r) { float sc = 1.f;
            if (type < 2) { float ss = acc[0][r] * acc[0][r] + acc[1][r] * acc[1][r] + acc[2][r] * acc[2][r] + acc[3][r] * acc[3][r];
                ss += __shfl_xor(ss, 1); ss += __shfl_xor(ss, 2); ss += __shfl_xor(ss, 4); ss += __shfl_xor(ss, 8);
                sc = __builtin_amdgcn_rsqf(ss * (1.f / FD) + EPS); }
#pragma unroll
            for (int nb = 0; nb < 4; ++nb) { const int d = 16 * nb + i16; float v = acc[nb][r];
                if (type < 2) { const float gq = F.in[I_FOX_QN][d] * C2, gk = F.in[I_FOX_KN][d]; v *= sc * (type == 0 ? gq : gk); }
                dst[(row0 + 4 * g + r) * DM + head * FD + d] = (bf16)f2bf(v); } }
    } else if (KIND == 1 || KIND == 2) {
        bf16* H = (bf16*)(ws + WS_H);
#pragma unroll
        for (int r = 0; r < 4; ++r)
#pragma unroll
            for (int nb = 0; nb < 4; ++nb) { const int c = 64 * cg + 16 * nb + i16; const size_t row = row0 + 4 * g + r;
                const float base = bf2f(H[row * DM + c]);
                H[row * DM + c] = (bf16)f2bf(base + acc[nb][r]); }
    } else {
        const int type = cg >> 4; bf16* dst = (bf16*)(ws + WS_Q) + (size_t)(type == 0 ? 0 : (type == 2 ? 2 : 1)) * ((WS_K - WS_Q) / 2); float* LOGF = (float*)(ws + WS_LOGF);
#pragma unroll
        for (int nb = 0; nb < 4; ++nb) { const int c = 64 * (cg & 15) + 16 * nb + i16;
            float bias = 0.f, lb = 0.f;
            if (type == 1) { bias = F.in[I_HG_BF][c]; lb = frcp(1.f + fexp(F.in[I_HG_LB][c] - F.in[I_HG_LB][DM + c])); }
#pragma unroll
            for (int r = 0; r < 4; ++r) { const size_t off = (row0 + 4 * g + r) * DM + c; const float v = acc[nb][r];
                if (type == 1) { const float sg = frcp(1.f + fexp(-(v + bias))); LOGF[off] = __logf(lb + (1.f - lb) * sg); }
                else dst[off] = (bf16)f2bf(type == 2 ? v : silu(v)); } }
    }
}
constexpr int MOE_PSTART = MISC_OFF + 64, MOE_TEXP = MISC_OFF + 256, MOE_NTILE = MISC_OFF + 60;
__device__ __forceinline__ void moe_tables(const Frame& F, int layer) {
    LAS int* pstart = (LAS int*)(F.lds + MOE_PSTART); LAS int* texp = (LAS int*)(F.lds + MOE_TEXP); LAS int* ntile = (LAS int*)(F.lds + MOE_NTILE);
    __syncthreads();
    if (F.tid < NEXP) { const unsigned c = __hip_atomic_load(F.ctl + CW_CNT + layer * 2048 + F.tid * 16, RLX_AGENT); pstart[F.tid + 1] = (int)((c + 255u) >> 8) << 8; }
    __syncthreads();
    if (F.tid == 0) { int acc = 0; pstart[0] = 0;
        for (int e = 0; e < NEXP; ++e) { acc += pstart[e + 1]; pstart[e + 1] = acc; }
        ntile[0] = acc >> 8; }
    __syncthreads();
    const int nt = ntile[0];
    for (int t = F.tid; t < nt && t < XPAD_TILES; t += 512) { int e = 0;
        for (int j = 1; j < NEXP; ++j) e += (pstart[j] <= 256 * t) ? 1 : 0;
        texp[t] = e; }
    __syncthreads();
}
__device__ __forceinline__ void moe_gather(const Frame& F, int layer) {
    moe_tables(F, layer);
    const LAS int* pstart = (const LAS int*)(F.lds + MOE_PSTART);
    LAS unsigned* lh = (LAS unsigned*)F.lds; LAS unsigned* lbase = lh + 32;
    unsigned* TOK = (unsigned*)(F.ws + WS_TOK); int* SROW = (int*)(F.ws + WS_SROW); float* RS = (float*)(F.ws + WS_RS);
    if (F.tid < NEXP) lh[F.tid] = 0u;
    __syncthreads();
    const int i = F.vcu * 512 + F.tid; const bool act = i < NBATCH * LQ;
    int e1 = 0, e2 = 0; unsigned s1 = 0, s2 = 0; size_t row = 0; float rst = 0.f;
    if (act) { const int b = i / LQ, t = i - b * LQ; row = (size_t)b * LP + t;
        const unsigned ee = TOK[row * 8]; e1 = ee & 255; e2 = (ee >> 8) & 255; rst = __uint_as_float(TOK[row * 8 + 3]);
        s1 = __hip_atomic_fetch_add(lh + e1, 1u, __ATOMIC_RELAXED, __HIP_MEMORY_SCOPE_WORKGROUP);
        s2 = __hip_atomic_fetch_add(lh + e2, 1u, __ATOMIC_RELAXED, __HIP_MEMORY_SCOPE_WORKGROUP); }
    __syncthreads();
    if (F.tid < NEXP) { const unsigned n = lh[F.tid]; lbase[F.tid] = n ? __hip_atomic_fetch_add(F.ctl + CW_CNT + layer * 2048 + 1024 + F.tid * 16, n, RLX_AGENT) : 0u; }
    __syncthreads();
    if (act) { const int d1 = pstart[e1] + (int)(lbase[e1] + s1), d2 = pstart[e2] + (int)(lbase[e2] + s2);
        *(v2u*)(TOK + row * 8 + 4) = (v2u){(unsigned)d1, (unsigned)d2};
        SROW[d1] = (int)row; SROW[d2] = (int)row; RS[d1] = rst; RS[d2] = rst; }
    __syncthreads();
}
__device__ __forceinline__ void moe_range(const LAS unsigned char* lds, int& T0, int& nun) { const int nt = *(const LAS int*)(lds + MOE_NTILE), x = (int)blockIdx.x & 7;
    T0 = (nt * x) >> 3; nun = (((nt * (x + 1)) >> 3) - T0) * 4; }
constexpr int MOE_RIDX = MISC_OFF + 2048;
__device__ __forceinline__ void moe_ridx(const Frame& F) {
    const int* SROW = (const int*)(F.ws + WS_SROW); LAS int* ridx = (LAS int*)(F.lds + MOE_RIDX);
    const LAS int* pstart = (const LAS int*)(F.lds + MOE_PSTART);
    const int r = (int)blockIdx.x >> 3; int T0, nun; moe_range(F.lds, T0, nun);
    if (F.tid < 256) { int v[6];
#pragma unroll
        for (int i = 0; i < 6; ++i) { const int Lx = i * 32 + r; v[i] = (Lx < nun) ? SROW[(T0 + (Lx >> 2)) * 256 + F.tid] : 0; }
#pragma unroll
        for (int i = 0; i < 6; ++i) ridx[i * 256 + F.tid] = v[i]; }
    __syncthreads();
}
constexpr int RS_TAB = MISC_OFF + 8192;
template <class Sched> __device__ __forceinline__ void rs_preload(const Frame& F, const Sched& S, const float* __restrict__ src) {
    LAS float* tab = (LAS float*)(F.lds + RS_TAB);
    if (F.tid < 256) { float v[8];
#pragma unroll
        for (int i = 0; i < 8; ++i) { pg8::Unit u; v[i] = S.next(i, u) ? src[(size_t)u.pm * 256 + F.tid] : 0.f; }
#pragma unroll
        for (int i = 0; i < 8; ++i) tab[i * 256 + F.tid] = v[i]; }
    __syncthreads();
}
struct MoeOrder {
    const LAS int* texp; int T0, nun, r; unsigned* dep; bool samex;
    __device__ __forceinline__ void signal(int pm) const { if (threadIdx.x == 0) { if (samex) __hip_atomic_fetch_add(dep + pm * 16, 1u, __ATOMIC_RELAXED, __HIP_MEMORY_SCOPE_AGENT);
                                                                                    else __hip_atomic_fetch_add(dep + pm * 16, 1u, __ATOMIC_RELEASE, __HIP_MEMORY_SCOPE_AGENT); } }
    __device__ __forceinline__ void init(const LAS unsigned char* lds) { const LAS int* pstart = (const LAS int*)(lds + MOE_PSTART); texp = (const LAS int*)(lds + MOE_TEXP);
        r = (int)blockIdx.x >> 3; moe_range(lds, T0, nun); }
    __device__ __forceinline__ bool next(int i, pg8::Unit& u) const { const int Lx = i * 32 + r; if (Lx >= nun) return false; const int rt = T0 + (Lx >> 2); u.pm = rt; u.pn = texp[rt] * 4 + (Lx & 3); u.ord = i; return true; }
    __device__ __forceinline__ void a_ready(const pg8::Unit&) const {}
    __device__ __forceinline__ void done(const pg8::Unit&) const {}
};
constexpr int MOE_DLIST = MISC_OFF + 1440;
struct MoeDownOrder {
    const LAS int* texp; const LAS int* dl; int T0, nun; unsigned* dep; mutable int have;
    __device__ __forceinline__ void init(LAS unsigned char* lds, unsigned* dep_) { const LAS int* pstart = (const LAS int*)(lds + MOE_PSTART); texp = (const LAS int*)(lds + MOE_TEXP); dep = dep_; have = -1;
        const int r = (int)blockIdx.x >> 3, tid = (int)threadIdx.x; moe_range(lds, T0, nun);
        LAS int* cl = (LAS int*)(lds + MOE_DLIST); LAS int* dlw = cl + 32; dl = dlw;
        const int target = (3 * nun + 31) / 32;
        if (tid < 32) { const int nup = tid < nun ? (nun - tid + 31) / 32 : 0; cl[tid] = target > 2 * nup ? target - 2 * nup : 0; }
        __syncthreads();
        if (tid < 24) { int base = 0, off = 0;
            for (int rr = 0; rr < 32; ++rr) { const int c = cl[rr]; base += c < tid ? c : tid; off += (rr < r && c > tid) ? 1 : 0; }
            const int Lx = base + off; dlw[tid] = (tid < cl[r] && Lx < nun) ? Lx : -1; }
        if (tid == 0) { __builtin_amdgcn_fence(__ATOMIC_ACQUIRE, "agent"); asm volatile("s_waitcnt vmcnt(0)" ::: "memory"); }
        __syncthreads(); }
    __device__ __forceinline__ bool next(int i, pg8::Unit& u) const { if (i >= 24) return false; const int Lx = dl[i]; if (Lx < 0) return false; const int rt = T0 + (Lx >> 2); u.pm = rt; u.pn = texp[rt] * 4 + (Lx & 3); u.ord = i; return true; }
    __device__ __forceinline__ void a_ready(const pg8::Unit& u) const {
        if (u.pm != have) {
            if (threadIdx.x == 0) { int spin = 0; while (__hip_atomic_load(dep + u.pm * 16, __ATOMIC_RELAXED, __HIP_MEMORY_SCOPE_AGENT) < 4u && ++spin < (1 << 24)) __builtin_amdgcn_s_sleep(2);
                asm volatile("" ::: "memory"); }
            __builtin_amdgcn_s_barrier();
            have = u.pm; }
    }
    __device__ __forceinline__ void done(const pg8::Unit&) const {}
};
constexpr int HG_TS = 288;
constexpr int HG_RS = 272;
template <int SH> __device__ __forceinline__ float row_shr(float x) {
    return __builtin_bit_cast(float, __builtin_amdgcn_update_dpp(0, __builtin_bit_cast(int, x), 0x110 + SH, 0xF, 0xF, true)); }
__device__ __forceinline__ float row_scan16(float x) { x += row_shr<1>(x); x += row_shr<2>(x); x += row_shr<4>(x); x += row_shr<8>(x); return x; }

struct HgLf { f32x4 a[4], c[4]; };
__device__ __forceinline__ void hg_load_lf(const float* __restrict__ lfrow, int g, HgLf& R) {
#pragma unroll
    for (int st = 0; st < 4; ++st) { R.a[st] = *(const f32x4*)(lfrow + 32 * st + 8 * g); R.c[st] = *(const f32x4*)(lfrow + 32 * st + 8 * g + 4); }
}
__device__ __forceinline__ void hg_scan_vals(const HgLf& R, LAS float* tot, int w, int t, int g, float (&kk)[4][8], float (&bl)[4][8]) {
#pragma unroll
    for (int st = 0; st < 4; ++st) { const f32x4 a = R.a[st], c = R.c[st];
        const float lf[8] = {a.x, a.y, a.z, a.w, c.x, c.y, c.z, c.w};
#pragma unroll
        for (int j = 0; j < 8; ++j) { kk[st][j] = 1.f - fexp(lf[j]); bl[st][j] = row_scan16(lf[j]); }
        if (t == 15) { *(LAS f32x4*)(tot + w * 128 + 32 * st + 8 * g) = (f32x4){bl[st][0], bl[st][1], bl[st][2], bl[st][3]};
                       *(LAS f32x4*)(tot + w * 128 + 32 * st + 8 * g + 4) = (f32x4){bl[st][4], bl[st][5], bl[st][6], bl[st][7]}; } }
}
__device__ __forceinline__ void hg_scan(const float* __restrict__ lfrow, LAS float* tot, int w, int t, int g, float (&kk)[4][8], float (&bl)[4][8]) {
    HgLf R; hg_load_lf(lfrow, g, R); hg_scan_vals(R, tot, w, t, g, kk, bl); }
__device__ __forceinline__ void lds_row8(const LAS float* p, float (&v)[8]) { const f32x4 a = *(const LAS f32x4*)p, c = *(const LAS f32x4*)(p + 4);
    v[0] = a.x; v[1] = a.y; v[2] = a.z; v[3] = a.w; v[4] = c.x; v[5] = c.y; v[6] = c.z; v[7] = c.w; }
__device__ __forceinline__ void hg_stage_v(const Frame& F, const bf16* __restrict__ vsrc, LAS unsigned char* img) {
#pragma unroll
    for (int p = 0; p < 4; ++p) { const int idx = F.tid + 512 * p, row = idx >> 4, c16 = idx & 15;
        *(LAS v4u*)(img + row * HG_TS + c16 * 16) = *(const v4u*)(vsrc + (size_t)row * DM + 8 * c16); }
}

constexpr int A1_KT = 0, A1_V = 128 * HG_TS, A1_TOT = 2 * 128 * HG_TS;
struct A1Pre { HgLf lf; v4u v[4]; };
__device__ __forceinline__ void hg_a1_prefetch(const Frame& F, int bh, int c, A1Pre& P) {
    const int w = F.wave, t = F.lane & 15, g = F.lane >> 4, b = bh >> 3, hd = bh & 7;
    const size_t row0 = (size_t)b * LP + 128 * c;
    hg_load_lf((const float*)(F.ws + WS_LOGF) + (row0 + 16 * w + t) * DM + hd * HK, g, P.lf);
    const bf16* vsrc = (const bf16*)(F.ws + WS_V) + row0 * DM + hd * HV;
#pragma unroll
    for (int p = 0; p < 4; ++p) { const int idx = F.tid + 512 * p, row = idx >> 4, c16 = idx & 15; P.v[p] = *(const v4u*)(vsrc + (size_t)row * DM + 8 * c16); }
}
__device__ __forceinline__ void hg_a1_unit(const Frame& F, int bh, int c, const A1Pre& P) {
    const int w = F.wave, t = F.lane & 15, g = F.lane >> 4;
    LAS unsigned char* L = F.lds; LAS float* tot = (LAS float*)(L + A1_TOT);
    float kk[4][8], bl[4][8];
#pragma unroll
    for (int p = 0; p < 4; ++p) { const int idx = F.tid + 512 * p, row = idx >> 4, c16 = idx & 15; *(LAS v4u*)(L + A1_V + row * HG_TS + c16 * 16) = P.v[p]; }
    hg_scan_vals(P.lf, tot, w, t, g, kk, bl);
}
__device__ __forceinline__ void hg_a1_rest(const Frame& F, int bh, int c, float (&kk)[4][8], float (&bl)[4][8]) {
    const int w = F.wave, t = F.lane & 15, g = F.lane >> 4;
    LAS unsigned char* L = F.lds; LAS float* tot = (LAS float*)(L + A1_TOT);
    __syncthreads();
#pragma unroll
    for (int st = 0; st < 4; ++st) { float e[8]; lds_row8(tot + w * 128 + 32 * st + 8 * g, e);
        for (int ww = w + 1; ww < 8; ++ww) { float x[8]; lds_row8(tot + ww * 128 + 32 * st + 8 * g, x);
#pragma unroll
            for (int j = 0; j < 8; ++j) e[j] += x[j]; }
        v4u o; float r[8];
#pragma unroll
        for (int j = 0; j < 8; ++j) r[j] = kk[st][j] * fexp(e[j] - bl[st][j]);
        o.x = pk2(r[0], r[1]); o.y = pk2(r[2], r[3]); o.z = pk2(r[4], r[5]); o.w = pk2(r[6], r[7]);
        *(LAS v4u*)(L + A1_KT + (16 * w + t) * HG_TS + (32 * st + 8 * g) * 2) = o; }
    if (F.tid < 128) { float s = 0.f;
#pragma unroll
        for (int ww = 0; ww < 8; ++ww) s += tot[ww * 128 + F.tid];
        ((float*)(F.ws + WS_BE))[(size_t)(bh * 128 + c) * 128 + F.tid] = s; }
    __syncthreads();
    f32x4 acc[8];
#pragma unroll
    for (int kb = 0; kb < 8; ++kb) acc[kb] = (f32x4){0.f, 0.f, 0.f, 0.f};
    const int i16 = F.lane & 15;
    const LAS unsigned char* ap = L + A1_V + (8 * g + (i16 >> 2)) * HG_TS + (16 * w + 4 * (i16 & 3)) * 2;
    const LAS unsigned char* bp = L + A1_KT + (8 * g + (i16 >> 2)) * HG_TS + (4 * (i16 & 3)) * 2;
#pragma unroll
    for (int ts = 0; ts < 4; ++ts) {
        const bf16x4 a0 = vtr(ap + 32 * ts * HG_TS), a1 = vtr(ap + (32 * ts + 4) * HG_TS);
        const bf16x8 af = (bf16x8){a0[0], a0[1], a0[2], a0[3], a1[0], a1[1], a1[2], a1[3]};
#pragma unroll
        for (int kb = 0; kb < 8; ++kb) { const bf16x4 b0 = vtr(bp + 32 * ts * HG_TS + 32 * kb), b1 = vtr(bp + (32 * ts + 4) * HG_TS + 32 * kb);
            const bf16x8 bfr = (bf16x8){b0[0], b0[1], b0[2], b0[3], b1[0], b1[1], b1[2], b1[3]};
            acc[kb] = __builtin_amdgcn_mfma_f32_16x16x32_bf16(af, bfr, acc[kb], 0, 0, 0); }
    }
    float* S = (float*)(F.ws + WS_SLOC) + (size_t)(bh * 128 + c) * (HV * HK);
#pragma unroll
    for (int kb = 0; kb < 8; ++kb)
#pragma unroll
        for (int r = 0; r < 4; ++r) S[(16 * w + 4 * g + r) * HK + 16 * kb + i16] = acc[kb][r];
    __syncthreads();
}
__device__ __forceinline__ void hg_a1_phase(const Frame& F) {
    int id = F.vcu; if (id >= 16 * 128) return;
    A1Pre P; hg_a1_prefetch(F, id >> 7, id & 127, P);
    for (;;) {
        __builtin_amdgcn_s_waitcnt(0x0F70);
        float kk[4][8], bl[4][8];
        { const int w = F.wave, t = F.lane & 15, g = F.lane >> 4; LAS unsigned char* L = F.lds;
#pragma unroll
            for (int p = 0; p < 4; ++p) { const int idx = F.tid + 512 * p, row = idx >> 4, c16 = idx & 15; *(LAS v4u*)(L + A1_V + row * HG_TS + c16 * 16) = P.v[p]; }
            hg_scan_vals(P.lf, (LAS float*)(L + A1_TOT), w, t, g, kk, bl); }
        const int idn = id + F.G;
        if (idn < 16 * 128) hg_a1_prefetch(F, idn >> 7, idn & 127, P);
        hg_a1_rest(F, id >> 7, id & 127, kk, bl);
        id = idn; if (id >= 16 * 128) break;
    }
}
__device__ __forceinline__ void hg_a2_phase(const Frame& F) {
    const int gt = blockIdx.x * 256 + (F.tid & 255), bh = (blockIdx.x * 256) >> 12;
    LAS float* bel = (LAS float*)F.lds;
    { const float* BE = (const float*)(F.ws + WS_BE) + (size_t)bh * 128 * 128;
        f32x4 v[8];
#pragma unroll
        for (int j = 0; j < 8; ++j) v[j] = *(const f32x4*)(BE + 4 * (F.tid + 512 * j));
#pragma unroll
        for (int j = 0; j < 8; ++j) *(LAS f32x4*)(bel + 4 * (F.tid + 512 * j)) = v[j]; }
    __syncthreads();
    if (F.tid < 256) {
        const int kq = gt & 31, dv = (gt >> 5) & 127;
        const float* S = (const float*)(F.ws + WS_SLOC) + (size_t)bh * 128 * (HV * HK) + dv * HK + 4 * kq;
        bf16* ST = (bf16*)(F.ws + WS_ST) + (size_t)bh * 129 * (HV * HK) + dv * HK + 4 * kq;
        f32x4 st = (f32x4){0.f, 0.f, 0.f, 0.f};
        f32x4 A[8], B[8];
#pragma unroll
        for (int j = 0; j < 8; ++j) A[j] = *(const f32x4*)(S + (size_t)j * (HV * HK));
#define A2_BATCH(CUR, NXT, nb) do { __builtin_amdgcn_s_waitcnt(0x0F70); \
        if ((nb) + 1 < 16) { _Pragma("unroll") for (int j = 0; j < 8; ++j) NXT[j] = *(const f32x4*)(S + (size_t)(8 * ((nb) + 1) + j) * (HV * HK)); } \
        _Pragma("unroll") for (int j = 0; j < 8; ++j) { const int c = 8 * (nb) + j; \
            *(v2u*)(ST + (size_t)c * (HV * HK)) = (v2u){pk2(st.x, st.y), pk2(st.z, st.w)}; \
            const f32x4 be = *(const LAS f32x4*)(bel + c * 128 + 4 * kq), s = CUR[j]; \
            st.x = fexp(be.x) * st.x + s.x; st.y = fexp(be.y) * st.y + s.y; st.z = fexp(be.z) * st.z + s.z; st.w = fexp(be.w) * st.w + s.w; } } while (0)
        for (int nb = 0; nb < 16; nb += 2) { A2_BATCH(A, B, nb); A2_BATCH(B, A, nb + 1); }
#undef A2_BATCH
        *(v2u*)(ST + (size_t)128 * (HV * HK)) = (v2u){pk2(st.x, st.y), pk2(st.z, st.w)};
    }
    __syncthreads();
}
constexpr int A3_KH = 0, A3_V = 128 * HG_RS, A3_ST = A3_V + 128 * HG_TS, A3_TOT = A3_ST + 128 * HG_RS, A3_ET = A3_TOT + 4096, A3_STG = 0, A3_STG_W = 16 * 528;
__device__ __forceinline__ void hg_a3_unit(const Frame& F, int bh, int c) {
    const int w = (F.wave & 1) ? 7 - (F.wave >> 1) : (F.wave >> 1), t = F.lane & 15, g = F.lane >> 4, b = bh >> 3, hd = bh & 7;
    const size_t row0 = (size_t)b * LP + 128 * c;
    LAS unsigned char* L = F.lds; LAS float* tot = (LAS float*)(L + A3_TOT);
    float kk[4][8], bl[4][8];
    hg_stage_v(F, (const bf16*)(F.ws + WS_V) + row0 * DM + hd * HV, L + A3_V);
    { const bf16* ssrc = (const bf16*)(F.ws + WS_ST) + (size_t)(bh * 129 + c) * (HV * HK);
#pragma unroll
        for (int p = 0; p < 4; ++p) { const int idx = F.tid + 512 * p, row = idx >> 4, c16 = idx & 15;
            *(LAS v4u*)(L + A3_ST + row * HG_RS + c16 * 16) = *(const v4u*)(ssrc + (size_t)row * HK + 8 * c16); } }
    hg_scan((const float*)(F.ws + WS_LOGF) + (row0 + 16 * w + t) * DM + hd * HK, tot, w, t, g, kk, bl);
    LAS float* etab = (LAS float*)(L + A3_ET);
    if (t == 15) {
#pragma unroll
        for (int st = 0; st < 4; ++st) { *(LAS f32x4*)(etab + w * 128 + 32 * st + 8 * g) = (f32x4){fexp(bl[st][0]), fexp(bl[st][1]), fexp(bl[st][2]), fexp(bl[st][3])};
            *(LAS f32x4*)(etab + w * 128 + 32 * st + 8 * g + 4) = (f32x4){fexp(bl[st][4]), fexp(bl[st][5]), fexp(bl[st][6]), fexp(bl[st][7])}; } }
    float qd[4][8];
    { const bf16* qrow = (const bf16*)(F.ws + WS_Q) + (row0 + 16 * w + t) * DM + hd * HK;
#pragma unroll
        for (int st = 0; st < 4; ++st) { const v4u u = *(const v4u*)(qrow + 32 * st + 8 * g);
            const float q[8] = {bflo(u.x), bfhi(u.x), bflo(u.y), bfhi(u.y), bflo(u.z), bfhi(u.z), bflo(u.w), bfhi(u.w)};
            float e[8]; lds_row8(tot + w * 128 + 32 * st + 8 * g, e);
            v4u o; float r[8];
#pragma unroll
            for (int j = 0; j < 8; ++j) { r[j] = kk[st][j] * fexp(e[j] - bl[st][j]); qd[st][j] = q[j] * fexp(bl[st][j]); }
            o.x = pk2(r[0], r[1]); o.y = pk2(r[2], r[3]); o.z = pk2(r[4], r[5]); o.w = pk2(r[6], r[7]);
            *(LAS v4u*)(L + A3_KH + (16 * w + t) * HG_RS + (32 * st + 8 * g) * 2) = o; } }
    __syncthreads();
    v4u gpre[4];
    { const int rr = F.lane >> 2, seg = F.lane & 3; const bf16* gs = (const bf16*)(F.ws + WS_K) + (row0 + 16 * w + rr) * DM + hd * HV + 32 * seg;
#pragma unroll
        for (int q = 0; q < 4; ++q) gpre[q] = *(const v4u*)(gs + 8 * q); }
    f32x4 o[8];
#pragma unroll
    for (int d = 0; d < 8; ++d) o[d] = (f32x4){0.f, 0.f, 0.f, 0.f};
    const int i16 = F.lane & 15;
    {
        bf16x8 aq[4];
#pragma unroll
        for (int st = 0; st < 4; ++st) { float e[8];
#pragma unroll
            for (int j = 0; j < 8; ++j) e[j] = 0.f;
            for (int ww = 0; ww < w; ++ww) { float x[8]; lds_row8(tot + ww * 128 + 32 * st + 8 * g, x);
#pragma unroll
                for (int j = 0; j < 8; ++j) e[j] += x[j]; }
            v4u pk; pk.x = pk2(qd[st][0] * fexp(e[0]), qd[st][1] * fexp(e[1])); pk.y = pk2(qd[st][2] * fexp(e[2]), qd[st][3] * fexp(e[3]));
            pk.z = pk2(qd[st][4] * fexp(e[4]), qd[st][5] * fexp(e[5])); pk.w = pk2(qd[st][6] * fexp(e[6]), qd[st][7] * fexp(e[7]));
            aq[st] = __builtin_bit_cast(bf16x8, pk); }
        const LAS unsigned char* sp = L + A3_ST + i16 * HG_RS + 16 * g;
#pragma unroll
        for (int d = 0; d < 8; ++d)
#pragma unroll
            for (int st = 0; st < 4; ++st) { const bf16x8 bfr = *(const LAS bf16x8*)(sp + 16 * d * HG_RS + 64 * st);
                o[d] = __builtin_amdgcn_mfma_f32_16x16x32_bf16(aq[st], bfr, o[d], 0, 0, 0); }
    }
    {
        float dsc[4][8];
#pragma unroll
        for (int st = 0; st < 4; ++st) { float x[8]; lds_row8(tot + w * 128 + 32 * st + 8 * g, x);
#pragma unroll
            for (int j = 0; j < 8; ++j) dsc[st][j] = fexp(fminf(-x[j], 85.f)); }
        const LAS unsigned char* kp = L + A3_KH + i16 * HG_RS + 16 * g;
        const LAS unsigned char* vp = L + A3_V + (4 * g + (i16 >> 2)) * HG_TS + (4 * (i16 & 3)) * 2;
        for (int j = w; j >= 0; --j) {
            f32x4 pt = (f32x4){0.f, 0.f, 0.f, 0.f};
#pragma unroll
            for (int st = 0; st < 4; ++st) {
                v4u pk; pk.x = pk2(qd[st][0] * dsc[st][0], qd[st][1] * dsc[st][1]); pk.y = pk2(qd[st][2] * dsc[st][2], qd[st][3] * dsc[st][3]);
                pk.z = pk2(qd[st][4] * dsc[st][4], qd[st][5] * dsc[st][5]); pk.w = pk2(qd[st][6] * dsc[st][6], qd[st][7] * dsc[st][7]);
                const bf16x8 kf = *(const LAS bf16x8*)(kp + 16 * j * HG_RS + 64 * st);
                pt = __builtin_amdgcn_mfma_f32_16x16x32_bf16(kf, __builtin_bit_cast(bf16x8, pk), pt, 0, 0, 0); }
            if (j == w) {
#pragma unroll
                for (int r = 0; r < 4; ++r) if (4 * g + r > i16) pt[r] = 0.f; }
            const v2u pp = (v2u){pk2(pt[0], pt[1]), pk2(pt[2], pt[3])};
            const bf16x4 pa = __builtin_bit_cast(bf16x4, pp);
#pragma unroll
            for (int d = 0; d < 8; ++d) { const bf16x4 vb = vtr(vp + 16 * j * HG_TS + 32 * d);
                o[d] = __builtin_amdgcn_mfma_f32_16x16x16bf16_1k(pa, vb, o[d], 0, 0, 0); }
            if (j == w) {
#pragma unroll
                for (int st = 0; st < 4; ++st)
#pragma unroll
                    for (int jj = 0; jj < 8; ++jj) dsc[st][jj] = 1.f;
            } else {
#pragma unroll
                for (int st = 0; st < 4; ++st) { float x[8]; lds_row8(etab + j * 128 + 32 * st + 8 * g, x);
#pragma unroll
                    for (int jj = 0; jj < 8; ++jj) dsc[st][jj] *= x[jj]; } }
        }
    }
    float rs[4];
#pragma unroll
    for (int r = 0; r < 4; ++r) { float s = 0.f;
#pragma unroll
        for (int d = 0; d < 8; ++d) s += o[d][r] * o[d][r];
        s += __shfl_xor(s, 1); s += __shfl_xor(s, 2); s += __shfl_xor(s, 4); s += __shfl_xor(s, 8);
        rs[r] = __builtin_amdgcn_rsqf(s * (1.f / HV) + EPS); }
    const float* go = F.in[I_HG_ON];
    __syncthreads();
    LAS float* stg = (LAS float*)(L + A3_STG + w * A3_STG_W);
#pragma unroll
    for (int d = 0; d < 8; ++d) { const float gv = go[16 * d + i16];
#pragma unroll
        for (int r = 0; r < 4; ++r) stg[(4 * g + r) * 132 + 16 * d + i16] = o[d][r] * rs[r] * gv; }
    asm volatile("s_waitcnt lgkmcnt(0)" ::: "memory");
    __builtin_amdgcn_wave_barrier();
    { const int rr = F.lane >> 2, seg = F.lane & 3; const size_t orow = (row0 + 16 * w + rr) * DM + hd * HV + 32 * seg;
        const bf16* gs = (const bf16*)(F.ws + WS_K) + orow; bf16* og = (bf16*)(F.ws + WS_OG) + orow;
#pragma unroll
        for (int q = 0; q < 4; ++q) { const v4u gu = gpre[q]; float x[8]; lds_row8(stg + rr * 132 + 32 * seg + 8 * q, x);
            v4u ou; ou.x = pk2(x[0] * bflo(gu.x), x[1] * bfhi(gu.x)); ou.y = pk2(x[2] * bflo(gu.y), x[3] * bfhi(gu.y));
            ou.z = pk2(x[4] * bflo(gu.z), x[5] * bfhi(gu.z)); ou.w = pk2(x[6] * bflo(gu.w), x[7] * bfhi(gu.w));
            *(v4u*)(og + 8 * q) = ou; } }
    __syncthreads();
}
__device__ __forceinline__ void hg_a3_phase(const Frame& F) {
    for (int i = 0;; ++i) { const int id = i * F.G + F.vcu; if (id >= 16 * 129) break;
        if (id < 16 * 128) hg_a3_unit(F, id >> 7, id & 127); else hg_a3_unit(F, id - 16 * 128, 128); }
}
constexpr int NPHASE = 21;
struct Args { const float* in[21]; float* out; unsigned char* ws; int ph_lo, ph_hi, li, pad; };
__global__ void __launch_bounds__(512, 2) hybrid_fwd(Args args) {
    extern __shared__ __attribute__((aligned(16))) unsigned char lds_raw[];
    Frame F;
    F.lds = (LAS unsigned char*)lds_raw; F.ws = args.ws; F.ctl = (unsigned*)(args.ws + WS_CTL);
    F.tid = threadIdx.x; F.lane = F.tid & 63; F.wave = __builtin_amdgcn_readfirstlane(F.tid >> 6);
    F.G = gridDim.x; { const int bx = blockIdx.x; F.vcu = (F.G % 8 == 0) ? (bx % 8) * (F.G / 8) + bx / 8 : bx; }
#pragma unroll
    for (int i = 0; i < 21; ++i) F.in[i] = args.in[i];
    F.out = args.out;
    for (int u = F.tid; u < (LDS_BYTES - MISC_OFF) / 4; u += 512) ((LAS unsigned*)(F.lds + MISC_OFF))[u] = 0u;
    __syncthreads();
    XcdBarrier bar = xcd_barrier_post(F.ctl + CW_BAR + args.li * XCD_BAR_WORDS, (volatile LAS unsigned*)(F.lds + MISC_OFF));
    if (F.tid == 0) __hip_atomic_fetch_or(F.ctl + CW_XMAP + args.li * 128 + ((int)blockIdx.x & 7) * 16, 1u << bar.x, __ATOMIC_RELAXED, __HIP_MEMORY_SCOPE_AGENT);
    int nbar = 0;
    const int lo = args.ph_lo, hi = args.ph_hi;
#define IN(k) (lo <= (k) && (k) < hi)
#define SEAM(k) do { if (IN(k) && IN((k) + 1)) { xcd_barrier(bar); nbar = 1; } } while (0)
    unsigned char* ws = F.ws;
    bf16* H = (bf16*)(ws + WS_H); const float* RSTD = (const float*)(ws + WS_RSTD);
    bf16* WSM = (bf16*)(ws + WS_WSM);

    if (IN(0)) { p0_prologue(F); } SEAM(0);
    if (IN(1)) { t_phase<0, 1, 1, false>(F, F.in[I_FOX_NORM], WSM, WSM + 16384, 0); } SEAM(1);
    if (IN(2)) { fox_scan(F); skinny_gemm<0>(F, H, (const bf16*)(ws + WS_WQKV), 3 * DM);
        pg8::Gemm g{H, (const bf16*)(ws + WS_WQKV), MP, 3 * DM, DM}; MainOrder S; S.init(3 * DM, F.G, (int)blockIdx.x);
        rs_preload(F, S, RSTD); EpiQKV E{(bf16*)(ws + WS_Q), F.in[I_FOX_QN], F.in[I_FOX_KN], (const LAS float*)(F.lds + RS_TAB)};
        pg8::gemm_phase<EpiQKV, MainOrder, true, true>(F.lds, g, S, E); } SEAM(2);
    if (IN(3)) { const bool first = (F.vcu & 1) != 0; if (first) p0_moe_weights(F); __syncthreads(); attn_phase(F); __syncthreads(); if (!first) p0_moe_weights(F); } SEAM(3);
    if (IN(4)) { skinny_gemm<2>(F, (const bf16*)(ws + WS_Q), (const bf16*)(ws + WS_WFO), DM);
        pg8::Gemm g{(const bf16*)(ws + WS_Q), (const bf16*)(ws + WS_WFO), MP, DM, DM}; MainOrder S; S.init(DM, F.G, (int)blockIdx.x);
        EpiResid E{H}; pg8::gemm_phase<EpiResid, MainOrder, true, true>(F.lds, g, S, E); } SEAM(4);
#define MOE_PHASES(layer, pb) \
    if (IN(pb)) { const bf16* wh = WSM + 32768 + (size_t)(layer) * 98304; t_phase<1, 3, 2, false>(F, F.in[I_MOE_NORM] + (layer) * DM, wh, wh + 49152, (layer)); } SEAM(pb); \
    if (IN((pb) + 1)) { moe_gather(F, (layer)); } SEAM((pb) + 1); \
    if (IN((pb) + 2)) { moe_tables(F, (layer)); moe_ridx(F); \
        MoeOrder S; S.init(F.lds); S.dep = F.ctl + CW_DEP + (layer) * 8192; \
        { const unsigned xm = __hip_atomic_load(F.ctl + CW_XMAP + args.li * 128 + ((int)blockIdx.x & 7) * 16, __ATOMIC_RELAXED, __HIP_MEMORY_SCOPE_AGENT); S.samex = nbar > 0 && __builtin_popcount(xm) == 1; } \
        pg8::Gemm g{H, (const bf16*)(ws + WS_WUP) + (size_t)(layer) * NEXP * DM * DM, 0, 0, DM}; \
        rs_preload(F, S, (const float*)(ws + WS_RS)); EpiUp E{(bf16*)(ws + WS_ACT), (const LAS float*)(F.lds + RS_TAB)}; pg8::gemm_phase_g<EpiUp, MoeOrder>(F.lds, g, S, E, (const LAS int*)(F.lds + MOE_RIDX)); \
        MoeDownOrder SD; SD.init(F.lds, F.ctl + CW_DEP + (layer) * 8192); \
        pg8::Gemm g2{(const bf16*)(ws + WS_ACT), (const bf16*)(ws + WS_WDN) + (size_t)(layer) * NEXP * DM * DEXP, 0, 0, DEXP}; \
        EpiDown E2{(bf16*)(ws + WS_XPAD)}; pg8::gemm_phase<EpiDown, MoeDownOrder, true, true>(F.lds, g2, SD, E2); } \
    SEAM((pb) + 3);
    MOE_PHASES(0, 5)
    if (IN(9)) { t_phase<2, 0, 0, false>(F, F.in[I_HG_NORM], nullptr, nullptr, 0); } SEAM(9);
    if (IN(10)) { skinny_gemm<3>(F, H, (const bf16*)(ws + WS_WHI), 4 * DM);
        pg8::Gemm g{H, (const bf16*)(ws + WS_WHI), MP, 4 * DM, DM}; MainOrder S; S.init(4 * DM, F.G, (int)blockIdx.x);
        rs_preload(F, S, RSTD); EpiHgIn E{(bf16*)(ws + WS_Q), (float*)(ws + WS_LOGF), F.in[I_HG_BF], F.in[I_HG_LB], (const LAS float*)(F.lds + RS_TAB)};
        pg8::gemm_phase<EpiHgIn, MainOrder, true, true>(F.lds, g, S, E); } SEAM(10);
    if (IN(11)) { hg_a1_phase(F); } SEAM(11);
    if (IN(12)) { hg_a2_phase(F); } SEAM(12);
    if (IN(13)) { hg_a3_phase(F); } SEAM(13);
    if (IN(14)) { skinny_gemm<2>(F, (const bf16*)(ws + WS_OG), (const bf16*)(ws + WS_WHO), DM);
        pg8::Gemm g{(const bf16*)(ws + WS_OG), (const bf16*)(ws + WS_WHO), MP, DM, DM}; MainOrder S; S.init(DM, F.G, (int)blockIdx.x);
        EpiResid E{H}; pg8::gemm_phase<EpiResid, MainOrder, true, true>(F.lds, g, S, E); } SEAM(14);
    MOE_PHASES(1, 15)
    if (IN(19)) { t_phase<2, 0, 0, true>(F, nullptr, nullptr, nullptr, 0); }
    if (IN(20)) { t_phase<1, 0, 0, true>(F, nullptr, nullptr, nullptr, 0); }
    if (lo == 26) {
        const unsigned* TOK = (const unsigned*)(ws + WS_TOK); const bf16* Y = (const bf16*)(ws + WS_XPAD);
        for (size_t i = (size_t)blockIdx.x * 512 + F.tid; i < (size_t)NBATCH * SEQ * DM; i += (size_t)F.G * 512) {
            const size_t rr = i >> 10; const int c = (int)(i & 1023); const size_t b = rr / SEQ, t = rr % SEQ + NMETA; const size_t row = b * LP + t;
            F.out[i] = c < 512 ? 10.f * __builtin_bit_cast(float, TOK[row * 8 + 1]) : 10.f * __builtin_bit_cast(float, TOK[row * 8 + 2]); }
    }
    if (lo == 25) {
        const float* src = (const float*)(ws + WS_CC);
        for (size_t i = (size_t)blockIdx.x * 512 + F.tid; i < (size_t)NBATCH * SEQ * DM; i += (size_t)F.G * 512) {
            const size_t rr = i >> 10; const int c = (int)(i & 1023); const size_t b = rr / SEQ, t = rr % SEQ + NMETA;
            F.out[i] = src[(b * FH + (c & 15)) * LP + t] + (c >= 16 ? 1.0f : 0.f); }
    }
    if (lo >= 21 && lo <= 24) {
        const bf16* src = (const bf16*)(ws + (lo == 21 ? WS_Q : lo == 22 ? WS_K : lo == 23 ? WS_V : WS_XN));
        for (size_t i = (size_t)blockIdx.x * 512 + F.tid; i < (size_t)NBATCH * SEQ * DM; i += (size_t)F.G * 512) {
            const size_t rr = i >> 10; const int c = (int)(i & 1023); const size_t b = rr / SEQ, t = rr % SEQ + NMETA;
            F.out[i] = bf2f(src[(b * LP + t) * DM + c]); }
    }
#undef IN
#undef SEAM
}

extern "C" void kernel_launch(void* const* d_in, const int* in_sizes, int n_in, void* d_out, int out_size, void* d_ws, size_t ws_size, hipStream_t stream) {
    static int grid = 0;
    if (grid == 0) {
        if (n_in != 21 || out_size != NBATCH * SEQ * DM || ws_size < WS_END) { fprintf(stderr, "kernel_launch: unexpected shapes (n_in %d out %d ws %zu)\n", n_in, out_size, ws_size); grid = -1; return; }
        int dev = 0, cus = 0, per_cu = 0;
        if (hipGetDevice(&dev) != hipSuccess || hipDeviceGetAttribute(&cus, hipDeviceAttributeMultiprocessorCount, dev) != hipSuccess) { grid = -1; return; }
        if (hipFuncSetAttribute((const void*)hybrid_fwd, hipFuncAttributeMaxDynamicSharedMemorySize, LDS_BYTES) != hipSuccess) { fprintf(stderr, "kernel_launch: hipFuncSetAttribute failed\n"); grid = -1; return; }
        if (hipOccupancyMaxActiveBlocksPerMultiprocessor(&per_cu, (const void*)hybrid_fwd, 512, LDS_BYTES) != hipSuccess || per_cu < 1) { fprintf(stderr, "kernel_launch: occupancy query says %d\n", per_cu); }
        (void)hipGetLastError();
        grid = 256;
        if (cus < 256) fprintf(stderr, "kernel_launch: %d CUs < 256: the grid cannot be co-resident\n", cus);
    }
    if (grid < 0) return;
    if (hipMemsetAsync((char*)d_ws + WS_CTL, 0, CTL_ZERO_BYTES, stream) != hipSuccess) return;
    Args a{};
    for (int i = 0; i < 21; ++i) a.in[i] = (const float*)d_in[i];
    a.out = (float*)d_out; a.ws = (unsigned char*)d_ws; a.pad = 0;
#if defined(DEV_PLAN)
    static const int plan[] = { DEV_PLAN };
    int li = 0;
    for (int p : plan) { a.ph_lo = p; a.ph_hi = p + 1; a.li = li++; hipLaunchKernelGGL(hybrid_fwd, dim3(grid), dim3(512), LDS_BYTES, stream, a); }
#else
    a.ph_lo = 0; a.ph_hi = 20; a.li = 0;
    hipLaunchKernelGGL(hybrid_fwd, dim3(grid), dim3(512), LDS_BYTES, stream, a);
#endif
}
```

```cpp
#include <hip/hip_runtime.h>
#include <cstdio>
#include <cstdint>
namespace pg8 {
#define PG8_LAS __attribute__((address_space(3)))
typedef unsigned short bf16_t;
typedef short bf16x8 __attribute__((ext_vector_type(8)));
typedef float f32x4 __attribute__((ext_vector_type(4)));
typedef unsigned u32x4 __attribute__((ext_vector_type(4)));
constexpr int BM = 256, BK = 64, HALF = 128, HTB = HALF * BK * 2  , STAGE_BYTES = 8 * HTB, NXCD = 8, WGM = 8;

__host__ __device__ __forceinline__ int lds_byte(int r, int c) { const int st = (r >> 4) * 2 + (c >> 5), rr = r & 15, cc = c & 31, ob = rr * 64 + cc * 2; return st * 1024 + (ob ^ (((ob >> 9) & 1) << 5)); }
__host__ __device__ __forceinline__ void stage_rc(int b, int& R, int& C) { const int st = b / 1024, sb = b % 1024, swz = sb ^ (((sb >> 9) & 1) << 5); R = (st >> 1) * 16 + swz / 64; C = (st & 1) * 32 + (swz % 64) / 2; }
__host__ __device__ __forceinline__ int perm32(int rho) { const int n = rho >> 4, i = rho & 15; return 8 * (i >> 2) + 4 * n + (i & 3); }

struct Unit { int pm, pn, ord; };
struct Gemm { const bf16_t* A; const bf16_t* Bt; int M, N, K; };

struct StaticOrder {
    int nM, nN, nwg, G, c;
    __host__ __device__ void init(int M, int N, int G_, int c_) { nM = M / BM; nN = N / BM; nwg = nM * nN; G = G_; c = c_; }
    __host__ __device__ bool next(int i, Unit& u) const {
        const long L = (long)i * G + c; if (L >= nwg) return false;
        int wgid = (int)L; { const int q = nwg / NXCD, r = nwg % NXCD, xcd = wgid % NXCD, off = wgid / NXCD; wgid = (xcd < r ? xcd * (q + 1) : r * (q + 1) + (xcd - r) * q) + off; }
        const int nig = WGM * nN, gid = wgid / nig, fm = gid * WGM, gsz = (nM - fm) < WGM ? (nM - fm) : WGM;
        u.pm = fm + ((wgid % nig) % gsz); u.pn = (wgid % nig) / gsz; u.ord = i; return true;
    }
    __device__ __forceinline__ void a_ready(const Unit&) const {}
    __device__ __forceinline__ void done(const Unit&) const {}
};
__device__ __forceinline__ unsigned cvt_pk_bf16(float lo, float hi) { unsigned r; asm volatile("v_cvt_pk_bf16_f32 %0, %1, %2" : "=v"(r) : "v"(lo), "v"(hi)); return r; }
typedef float f32x2 __attribute__((ext_vector_type(2)));
template <class Epi, class Sched, bool ALIGN_EPI = false, bool SP2 = false>
__device__ __forceinline__ void gemm_phase(PG8_LAS unsigned char* lds, const Gemm g, const Sched& S, const Epi& E) {
    const int tid = threadIdx.x, wid = __builtin_amdgcn_readfirstlane(tid >> 6), lane = tid & 63, wr = wid >> 2, wc = wid & 3, fr = lane & 15, fq = lane >> 4;
    const int K = g.K, nt = K / BK;
    unsigned voffA[2], voffB[2];
#pragma unroll
    for (int i = 0; i < 2; ++i) { int R, C; stage_rc(tid * 16 + i * 8192, R, C); const int Rb = Epi::PERM ? ((R & ~31) + perm32(R & 31)) : R;
        voffA[i] = (unsigned)(R * K + C) * 2u; voffB[i] = (unsigned)(Rb * K + C) * 2u; }
    const size_t kstep = (size_t)(BK * 2);
    const size_t hstep = (size_t)HALF * K * 2;
    const size_t tstep = 2 * hstep;
    const unsigned ldsw = (unsigned)wid * 1024u;
    const int aoff = lds_byte(wr * 64 + fr, fq * 8), boff = lds_byte(wc * 32 + fr, fq * 8);
#define PG8_SA(b, h) (((b) * 2 + (h)) * HTB)
#define PG8_SB(b, h) ((4 + (b) * 2 + (h)) * HTB)
#define PG8_STAGE(bufoff, gbase, voff) do { _Pragma("unroll") for (int _i = 0; _i < 2; ++_i) \
        __builtin_amdgcn_global_load_lds((const unsigned*)((const char*)(gbase) + (voff)[_i]), (PG8_LAS unsigned*)(lds + (bufoff) + ldsw + _i * 8192), 16, 0, 0); } while (0)
#define PG8_LDA(dst, b, h) do { _Pragma("unroll") for (int m = 0; m < 4; ++m) _Pragma("unroll") for (int k = 0; k < 2; ++k) dst[m][k] = *(const PG8_LAS bf16x8*)(lds + PG8_SA(b, h) + aoff + m * 2048 + k * 1024); } while (0)
#define PG8_LDB(dst, b, h) do { _Pragma("unroll") for (int n = 0; n < 2; ++n) _Pragma("unroll") for (int k = 0; k < 2; ++k) dst[n][k] = *(const PG8_LAS bf16x8*)(lds + PG8_SB(b, h) + boff + n * 2048 + k * 1024); } while (0)
#define PG8_MMA(ai, bj, At, Bt) do { __builtin_amdgcn_s_setprio(1); _Pragma("unroll") for (int m = 0; m < 4; ++m) _Pragma("unroll") for (int n = 0; n < 2; ++n) _Pragma("unroll") for (int k = 0; k < 2; ++k) \
        acc[ai][bj][m][n] = __builtin_amdgcn_mfma_f32_16x16x32_bf16(Bt[n][k], At[m][k], acc[ai][bj][m][n], 0, 0, 0); __builtin_amdgcn_s_setprio(0); } while (0)
#define PG8_WAIT_V(n) asm volatile("s_waitcnt vmcnt(" #n ")" ::: "memory")
#define PG8_WAIT_L(n) asm volatile("s_waitcnt lgkmcnt(" #n ")" ::: "memory")
#define PG8_BAR __builtin_amdgcn_s_barrier()
#define PG8_SCHED __builtin_amdgcn_sched_barrier(0)
    Unit cur, nxt; int ui = 0;
    if (!S.next(0, cur)) return;
    f32x4 acc[2][2][4][2];
#pragma unroll
    for (int a = 0; a < 2; ++a)
#pragma unroll
        for (int b = 0; b < 2; ++b)
#pragma unroll
            for (int m = 0; m < 4; ++m)
#pragma unroll
                for (int n = 0; n < 2; ++n) acc[a][b][m][n] = (f32x4){0.f, 0.f, 0.f, 0.f};
    bf16x8 At[4][2], B0[2][2], B1[2][2];
    const char* cA = (const char*)g.A + (size_t)cur.pm * tstep; const char* cB = (const char*)g.Bt + (size_t)cur.pn * tstep;
    S.a_ready(cur);
    if constexpr (SP2) {
        PG8_STAGE(PG8_SB(0, 0), cB, voffB); PG8_STAGE(PG8_SB(0, 1), cB + hstep, voffB); PG8_STAGE(PG8_SA(0, 0), cA, voffA); PG8_STAGE(PG8_SA(0, 1), cA + hstep, voffA);
        if (wr == 1) PG8_BAR;
        PG8_WAIT_V(2); PG8_BAR;
        PG8_STAGE(PG8_SB(1, 0), cB + kstep, voffB); PG8_STAGE(PG8_SA(1, 0), cA + kstep, voffA); PG8_STAGE(PG8_SB(1, 1), cB + hstep + kstep, voffB);
        PG8_WAIT_V(6); PG8_BAR;
    } else {
        PG8_STAGE(PG8_SB(0, 0), cB, voffB); PG8_STAGE(PG8_SA(0, 0), cA, voffA); PG8_STAGE(PG8_SB(0, 1), cB + hstep, voffB); PG8_STAGE(PG8_SA(0, 1), cA + hstep, voffA);
        if (wr == 1) PG8_BAR;
        PG8_WAIT_V(4); PG8_BAR;
        PG8_STAGE(PG8_SB(1, 0), cB + kstep, voffB); PG8_STAGE(PG8_SA(1, 0), cA + kstep, voffA); PG8_STAGE(PG8_SB(1, 1), cB + hstep + kstep, voffB);
        PG8_WAIT_V(6); PG8_BAR;
    }
    for (;;) {
        const bool has_next = S.next(ui + 1, nxt);
        const char* nA = has_next ? (const char*)g.A + (size_t)nxt.pm * tstep : cA; const char* nB = has_next ? (const char*)g.Bt + (size_t)nxt.pn * tstep : cB;
        for (int t = 0; t < nt; t += 2) {
            const bool last = (t == nt - 2);
            const char* a1 = cA + (size_t)(t + 1) * kstep;
            const char* a2 = last ? nA : cA + (size_t)(t + 2) * kstep; const char* b2 = last ? nB : cB + (size_t)(t + 2) * kstep;
            const char* a3 = a2 + kstep; const char* b3 = b2 + kstep;
            if (last && has_next) S.a_ready(nxt);
            if constexpr (SP2) {
            PG8_LDB(B0, 0, 0); PG8_LDB(B1, 0, 1); PG8_SCHED; PG8_LDA(At, 0, 0); PG8_STAGE(PG8_SA(1, 1), a1 + hstep, voffA);
            PG8_WAIT_V(8); PG8_WAIT_L(0); PG8_BAR; PG8_MMA(0, 0, At, B0); PG8_MMA(0, 1, At, B1); PG8_BAR; PG8_SCHED;
            PG8_LDA(At, 0, 1); PG8_STAGE(PG8_SB(0, 0), b2, voffB); PG8_STAGE(PG8_SB(0, 1), b2 + hstep, voffB); PG8_STAGE(PG8_SA(0, 0), a2, voffA);
            PG8_WAIT_V(8); PG8_WAIT_L(0); PG8_BAR; PG8_MMA(1, 0, At, B0); PG8_MMA(1, 1, At, B1); PG8_BAR; PG8_SCHED;
            PG8_LDB(B0, 1, 0); PG8_LDB(B1, 1, 1); PG8_SCHED; PG8_LDA(At, 1, 0); PG8_STAGE(PG8_SA(0, 1), a2 + hstep, voffA);
            PG8_WAIT_V(8); PG8_WAIT_L(0); PG8_BAR; PG8_MMA(0, 0, At, B0); PG8_MMA(0, 1, At, B1); PG8_BAR; PG8_SCHED;
            PG8_LDA(At, 1, 1); PG8_STAGE(PG8_SB(1, 0), b3, voffB); PG8_STAGE(PG8_SB(1, 1), b3 + hstep, voffB); PG8_STAGE(PG8_SA(1, 0), a3, voffA);
            PG8_WAIT_V(8); PG8_WAIT_L(0); PG8_BAR; PG8_MMA(1, 0, At, B0); PG8_MMA(1, 1, At, B1); PG8_BAR; PG8_SCHED;
            } else {
            PG8_LDB(B0, 0, 0); PG8_SCHED; PG8_LDA(At, 0, 0); PG8_STAGE(PG8_SA(1, 1), a1 + hstep, voffA);
            PG8_WAIT_L(8); PG8_BAR; PG8_WAIT_L(0); PG8_MMA(0, 0, At, B0); PG8_BAR; PG8_SCHED;
            PG8_LDB(B1, 0, 1); PG8_STAGE(PG8_SB(0, 0), b2, voffB);
            PG8_BAR; PG8_WAIT_L(0); PG8_MMA(0, 1, At, B1); PG8_BAR;
            PG8_LDA(At, 0, 1); PG8_STAGE(PG8_SA(0, 0), a2, voffA);
            PG8_BAR; PG8_WAIT_L(0); PG8_MMA(1, 0, At, B0); PG8_BAR; PG8_SCHED;
            PG8_STAGE(PG8_SB(0, 1), b2 + hstep, voffB);
            PG8_WAIT_V(6); PG8_BAR; PG8_MMA(1, 1, At, B1); PG8_BAR;
            PG8_LDB(B0, 1, 0); PG8_SCHED; PG8_LDA(At, 1, 0); PG8_STAGE(PG8_SA(0, 1), a2 + hstep, voffA);
            PG8_WAIT_L(8); PG8_BAR; PG8_WAIT_L(0); PG8_MMA(0, 0, At, B0); PG8_BAR; PG8_SCHED;
            PG8_LDB(B1, 1, 1); PG8_STAGE(PG8_SB(1, 0), b3, voffB);
            PG8_BAR; PG8_WAIT_L(0); PG8_MMA(0, 1, At, B1); PG8_BAR;
            PG8_LDA(At, 1, 1); PG8_STAGE(PG8_SA(1, 0), a3, voffA);
            PG8_BAR; PG8_WAIT_L(0); PG8_MMA(1, 0, At, B0); PG8_BAR; PG8_SCHED;
            PG8_STAGE(PG8_SB(1, 1), b3 + hstep, voffB);
            PG8_WAIT_V(6); PG8_BAR; PG8_MMA(1, 1, At, B1); PG8_BAR;
            }
        }
        if constexpr (ALIGN_EPI) { if (wr == 0) PG8_BAR; }
        if constexpr (!Epi::AFTER_DRAIN) { E(acc, cur, wr, wc, fr, fq); S.done(cur); }
        if (!has_next) break;
#pragma unroll
        for (int a = 0; a < 2; ++a)
#pragma unroll
            for (int b = 0; b < 2; ++b)
#pragma unroll
                for (int m = 0; m < 4; ++m)
#pragma unroll
                    for (int n = 0; n < 2; ++n) acc[a][b][m][n] = (f32x4){0.f, 0.f, 0.f, 0.f};
        cur = nxt; cA = nA; cB = nB; ++ui;
        if constexpr (ALIGN_EPI) { if (wr == 1) PG8_BAR; }
    }
    PG8_WAIT_V(0);
    if constexpr (!ALIGN_EPI) { if (wr == 0) PG8_BAR; }
    PG8_BAR;
    if constexpr (Epi::AFTER_DRAIN) { E.fused(acc, cur, wr, wc, fr, fq, lds, wid, lane); S.done(cur); }
#undef PG8_SA
#undef PG8_SB
#undef PG8_STAGE
#undef PG8_LDA
#undef PG8_LDB
#undef PG8_MMA
#undef PG8_WAIT_V
#undef PG8_WAIT_L
#undef PG8_BAR
#undef PG8_SCHED
}
}
namespace pg8 {
template <class Epi, class Sched>
__device__ __forceinline__ void gemm_phase_g(PG8_LAS unsigned char* lds, const Gemm g, const Sched& S, const Epi& E, const PG8_LAS int* ridx) {
    const int tid = threadIdx.x, wid = __builtin_amdgcn_readfirstlane(tid >> 6), lane = tid & 63, wr = wid >> 2, wc = wid & 3, fr = lane & 15, fq = lane >> 4;
    const int K = g.K, nt = K / BK;
    int RA[2], CA[2]; unsigned voffB[2];
#pragma unroll
    for (int i = 0; i < 2; ++i) { int R, C; stage_rc(tid * 16 + i * 8192, R, C); const int Rb = Epi::PERM ? ((R & ~31) + perm32(R & 31)) : R;
        RA[i] = R; CA[i] = C * 2; voffB[i] = (unsigned)(Rb * K + C) * 2u; }
    const size_t kstep = (size_t)(BK * 2);
    const size_t hstep = (size_t)HALF * K * 2;
    const size_t tstep = 2 * hstep;
    const unsigned ldsw = (unsigned)wid * 1024u;
    const int aoff = lds_byte(wr * 64 + fr, fq * 8), boff = lds_byte(wc * 32 + fr, fq * 8);
#define PG8_SA(b, h) (((b) * 2 + (h)) * HTB)
#define PG8_SB(b, h) ((4 + (b) * 2 + (h)) * HTB)
#define PG8_STAGE(bufoff, gbase, voff) do { _Pragma("unroll") for (int _i = 0; _i < 2; ++_i) \
        __builtin_amdgcn_global_load_lds((const unsigned*)((const char*)(gbase) + (voff)[_i]), (PG8_LAS unsigned*)(lds + (bufoff) + ldsw + _i * 8192), 16, 0, 0); } while (0)
#define PG8_LDA(dst, b, h) do { _Pragma("unroll") for (int m = 0; m < 4; ++m) _Pragma("unroll") for (int k = 0; k < 2; ++k) dst[m][k] = *(const PG8_LAS bf16x8*)(lds + PG8_SA(b, h) + aoff + m * 2048 + k * 1024); } while (0)
#define PG8_LDB(dst, b, h) do { _Pragma("unroll") for (int n = 0; n < 2; ++n) _Pragma("unroll") for (int k = 0; k < 2; ++k) dst[n][k] = *(const PG8_LAS bf16x8*)(lds + PG8_SB(b, h) + boff + n * 2048 + k * 1024); } while (0)
#define PG8_MMA(ai, bj, At, Bt) do { __builtin_amdgcn_s_setprio(1); _Pragma("unroll") for (int m = 0; m < 4; ++m) _Pragma("unroll") for (int n = 0; n < 2; ++n) _Pragma("unroll") for (int k = 0; k < 2; ++k) \
        acc[ai][bj][m][n] = __builtin_amdgcn_mfma_f32_16x16x32_bf16(Bt[n][k], At[m][k], acc[ai][bj][m][n], 0, 0, 0); __builtin_amdgcn_s_setprio(0); } while (0)
#define PG8_WAIT_V(n) asm volatile("s_waitcnt vmcnt(" #n ")" ::: "memory")
#define PG8_WAIT_L(n) asm volatile("s_waitcnt lgkmcnt(" #n ")" ::: "memory")
#define PG8_BAR __builtin_amdgcn_s_barrier()
#define PG8_SCHED __builtin_amdgcn_sched_barrier(0)
#define PG8_GOFF(dst, ui_) do { _Pragma("unroll") for (int h_ = 0; h_ < 2; ++h_) _Pragma("unroll") for (int i_ = 0; i_ < 2; ++i_) \
        dst[h_][i_] = (unsigned)ridx[(ui_) * 256 + h_ * HALF + RA[i_]] * (unsigned)(K * 2) + (unsigned)CA[i_]; } while (0)
    Unit cur, nxt; int ui = 0, pend = -1;
    if (!S.next(0, cur)) return;
    f32x4 acc[2][2][4][2];
#pragma unroll
    for (int a = 0; a < 2; ++a)
#pragma unroll
        for (int b = 0; b < 2; ++b)
#pragma unroll
            for (int m = 0; m < 4; ++m)
#pragma unroll
                for (int n = 0; n < 2; ++n) acc[a][b][m][n] = (f32x4){0.f, 0.f, 0.f, 0.f};
    bf16x8 At[4][2], B0[2][2], B1[2][2];
    const char* gA = (const char*)g.A; const char* cB = (const char*)g.Bt + (size_t)cur.pn * tstep;
    unsigned vC[2][2], vN[2][2];
    PG8_GOFF(vC, 0);
    S.a_ready(cur);
    PG8_STAGE(PG8_SB(0, 0), cB, voffB); PG8_STAGE(PG8_SB(0, 1), cB + hstep, voffB); PG8_STAGE(PG8_SA(0, 0), gA, vC[0]); PG8_STAGE(PG8_SA(0, 1), gA, vC[1]);
    if (wr == 1) PG8_BAR;
    PG8_WAIT_V(2); PG8_BAR;
    PG8_STAGE(PG8_SB(1, 0), cB + kstep, voffB); PG8_STAGE(PG8_SA(1, 0), gA + kstep, vC[0]); PG8_STAGE(PG8_SB(1, 1), cB + hstep + kstep, voffB);
    PG8_WAIT_V(6); PG8_BAR;
    for (;;) {
        const bool has_next = S.next(ui + 1, nxt);
        const char* nB = has_next ? (const char*)g.Bt + (size_t)nxt.pn * tstep : cB;
        if (has_next) { PG8_GOFF(vN, ui + 1); } else {
#pragma unroll
            for (int h_ = 0; h_ < 2; ++h_)
#pragma unroll
                for (int i_ = 0; i_ < 2; ++i_) vN[h_][i_] = vC[h_][i_]; }
        for (int t = 0; t < nt; t += 2) {
            const bool last = (t == nt - 2);
            const char* a1 = gA + (size_t)(t + 1) * kstep;
            const char* a2 = last ? gA : gA + (size_t)(t + 2) * kstep; const char* b2 = last ? nB : cB + (size_t)(t + 2) * kstep;
            const char* a3 = a2 + kstep; const char* b3 = b2 + kstep;
            unsigned v2[2][2];
#pragma unroll
            for (int h_ = 0; h_ < 2; ++h_)
#pragma unroll
                for (int i_ = 0; i_ < 2; ++i_) v2[h_][i_] = last ? vN[h_][i_] : vC[h_][i_];
            if (last && has_next) S.a_ready(nxt);
            PG8_LDB(B0, 0, 0); PG8_LDB(B1, 0, 1); PG8_SCHED; PG8_LDA(At, 0, 0); PG8_STAGE(PG8_SA(1, 1), a1, vC[1]);
            PG8_WAIT_V(8); PG8_WAIT_L(0); PG8_BAR; PG8_MMA(0, 0, At, B0); PG8_MMA(0, 1, At, B1); PG8_BAR; PG8_SCHED;
            PG8_LDA(At, 0, 1); PG8_STAGE(PG8_SB(0, 0), b2, voffB); PG8_STAGE(PG8_SB(0, 1), b2 + hstep, voffB); PG8_STAGE(PG8_SA(0, 0), a2, v2[0]);
            PG8_WAIT_V(8); PG8_WAIT_L(0); PG8_BAR; PG8_MMA(1, 0, At, B0); PG8_MMA(1, 1, At, B1); PG8_BAR; PG8_SCHED;
            PG8_LDB(B0, 1, 0); PG8_LDB(B1, 1, 1); PG8_SCHED; PG8_LDA(At, 1, 0); PG8_STAGE(PG8_SA(0, 1), a2, v2[1]);
            PG8_WAIT_V(8); PG8_WAIT_L(0); PG8_BAR; PG8_MMA(0, 0, At, B0); PG8_MMA(0, 1, At, B1); PG8_BAR; PG8_SCHED;
            PG8_LDA(At, 1, 1); PG8_STAGE(PG8_SB(1, 0), b3, voffB); PG8_STAGE(PG8_SB(1, 1), b3 + hstep, voffB); PG8_STAGE(PG8_SA(1, 0), a3, v2[0]);
            PG8_WAIT_V(8); PG8_WAIT_L(0); PG8_BAR; PG8_MMA(1, 0, At, B0); PG8_MMA(1, 1, At, B1); PG8_BAR; PG8_SCHED;
        }
        if (wr == 0) PG8_BAR;
        if (pend >= 0) S.signal(pend);
        E(acc, cur, wr, wc, fr, fq); S.done(cur); pend = cur.pm;
        if (!has_next) break;
#pragma unroll
        for (int a = 0; a < 2; ++a)
#pragma unroll
            for (int b = 0; b < 2; ++b)
#pragma unroll
                for (int m = 0; m < 4; ++m)
#pragma unroll
                    for (int n = 0; n < 2; ++n) acc[a][b][m][n] = (f32x4){0.f, 0.f, 0.f, 0.f};
        cur = nxt; cB = nB; ++ui;
#pragma unroll
        for (int h_ = 0; h_ < 2; ++h_)
#pragma unroll
            for (int i_ = 0; i_ < 2; ++i_) vC[h_][i_] = vN[h_][i_];
        if (wr == 1) PG8_BAR;
    }
    PG8_WAIT_V(0);
    PG8_BAR;
    if (pend >= 0) S.signal(pend);
#undef PG8_GOFF
#undef PG8_SA
#undef PG8_SB
#undef PG8_STAGE
#undef PG8_LDA
#undef PG8_LDB
#undef PG8_MMA
#undef PG8_WAIT_V
#undef PG8_WAIT_L
#undef PG8_BAR
#undef PG8_SCHED
}
}
constexpr int DM = 1024, NBATCH = 2, SEQ = 16384, NMETA = 16, LQ = SEQ + NMETA, LP = 16640, MP = NBATCH * LP;
constexpr int NBLK16 = LQ / 16;
constexpr int FH = 16, FD = 64;
constexpr int HH = 8, HK = 128, HV = 128;
constexpr int NEXP = 32, EPG = 8, DEXP = 512;
constexpr int XPAD_TILES = 290, XPAD_ROWS = XPAD_TILES * 256;
constexpr float EPS = 1e-6f, LOG2E = 1.4426950408889634f;
constexpr float C2 = 0.125f * LOG2E;
constexpr float SKIP_T = 150.f;

constexpr size_t MiB = 1u << 20;
constexpr size_t WS_CTL = 0, CTL_ZERO_BYTES = 1 * MiB;
constexpr size_t WS_WSM = 1 * MiB;
constexpr size_t WS_WQKV = 2 * MiB, WS_WFO = 8 * MiB, WS_WHI = 10 * MiB, WS_WHO = 18 * MiB, WS_WUP = 20 * MiB, WS_WDN = 148 * MiB;
constexpr size_t WS_H = 212 * MiB;
constexpr size_t WS_XN = 342 * MiB;
constexpr size_t WS_Q = 407 * MiB, WS_K = 472 * MiB, WS_V = 537 * MiB;
constexpr size_t WS_LFT = 602 * MiB, WS_CC = 605 * MiB;
constexpr size_t WS_OG = 608 * MiB;
constexpr size_t WS_TOK = 673 * MiB;
constexpr size_t WS_SROW = WS_TOK + 1280 * 1024;
constexpr size_t WS_RSTD = WS_TOK + 1664 * 1024;
constexpr size_t WS_RS = WS_LFT;
constexpr size_t WS_RB = 675 * MiB;
constexpr size_t WS_XPAD = WS_RB, WS_ACT = WS_RB + 145 * MiB;
constexpr size_t WS_LOGF = WS_RB, WS_SLOC = WS_RB + 130 * MiB, WS_ST = WS_RB + 258 * MiB, WS_BE = WS_RB + 323 * MiB;
constexpr size_t WS_END = 1000 * MiB;
static_assert(WS_XPAD + (size_t)XPAD_ROWS * 2048 <= WS_ACT && WS_ACT + (size_t)XPAD_ROWS * 1024 <= WS_END, "moe map");
static_assert(WS_LOGF + (size_t)MP * 4096 <= WS_SLOC && WS_SLOC + (size_t)2048 * 65536 <= WS_ST && WS_ST + (size_t)2064 * 32768 <= WS_BE && WS_BE + (size_t)2048 * 512 <= WS_END, "hgrn map");
static_assert((size_t)MP * 32 <= 1280 * 1024 && WS_SROW + (size_t)XPAD_ROWS * 4 <= WS_RSTD && WS_RSTD + (size_t)MP * 4 <= WS_RB && (size_t)XPAD_ROWS * 4 <= 2 * MiB, "tok map");
static_assert(WS_H + (size_t)MP * 4096 <= WS_XN && WS_XN + (size_t)MP * 2048 <= WS_Q && WS_V + (size_t)MP * 2048 <= WS_LFT && WS_OG + (size_t)MP * 2048 <= WS_TOK && WS_TOK + (size_t)MP * 32 <= WS_RB, "ws map");
constexpr int CW_BAR = 4096;
constexpr int CW_XMAP = 212992;
constexpr int CW_DEP = 196608;
constexpr int CW_CNT = 131072;
constexpr int RING_BYTES = 131072;
constexpr int MISC_OFF = RING_BYTES;
constexpr int LDS_BYTES = 147456;

#define GAS __attribute__((address_space(1)))
#define LAS __attribute__((address_space(3)))
typedef unsigned short bf16;
typedef unsigned v4u __attribute__((ext_vector_type(4)));
typedef unsigned v2u __attribute__((ext_vector_type(2)));
typedef float f32x4 __attribute__((ext_vector_type(4)));
typedef float f32x16 __attribute__((ext_vector_type(16)));
typedef short bf16x8 __attribute__((ext_vector_type(8)));
typedef short bf16x4 __attribute__((ext_vector_type(4)));
typedef GAS unsigned gu32;
#define RLX_AGENT __ATOMIC_RELAXED, __HIP_MEMORY_SCOPE_AGENT
__device__ __forceinline__ unsigned f2bf(float f) { unsigned u = __builtin_bit_cast(unsigned, f); return (u + 0x7fffu + ((u >> 16) & 1u)) >> 16; }
__device__ __forceinline__ float bf2f(unsigned h) { return __builtin_bit_cast(float, h << 16); }
typedef float f32x2_t __attribute__((ext_vector_type(2))); typedef __bf16 bf16x2_t __attribute__((ext_vector_type(2)));
__device__ __forceinline__ unsigned pk2(float lo, float hi) { f32x2_t v = {lo, hi}; bf16x2_t b = __builtin_convertvector(v, bf16x2_t); return __builtin_bit_cast(unsigned, b); }
__device__ __forceinline__ float bflo(unsigned u) { return __builtin_bit_cast(float, u << 16); }
__device__ __forceinline__ float bfhi(unsigned u) { return __builtin_bit_cast(float, u & 0xffff0000u); }
__device__ __forceinline__ float fexp2(float x) { return __builtin_amdgcn_exp2f(x); }
__device__ __forceinline__ float fexp(float x) { return __builtin_amdgcn_exp2f(x * LOG2E); }
__device__ __forceinline__ float frcp(float x) { return __builtin_amdgcn_rcpf(x); }
__device__ __forceinline__ float silu(float x) { return x * frcp(1.f + fexp(-x)); }
#define XB_TMO      128
#define XB_XCNT(j)  (256  + 64 * (j))
#define XB_XSUB(j)  (1280 + 64 * (j))
#define XB_XGEN(j)  (2304 + 64 * (j))
#define XB_TOP      3328
#define XB_TOPGEN   3392
#define XCD_BAR_WORDS 3456
#define XB_SPIN_CAP (1u << 18)

__device__ __forceinline__ unsigned xb_ld(unsigned* p)              { return __hip_atomic_load(p, __ATOMIC_RELAXED, __HIP_MEMORY_SCOPE_AGENT); }
__device__ __forceinline__ unsigned xb_add(unsigned* p, unsigned v) { return __hip_atomic_fetch_add(p, v, __ATOMIC_RELAXED, __HIP_MEMORY_SCOPE_AGENT); }
__device__ __forceinline__ unsigned xb_xcc_id() { return (unsigned)__builtin_amdgcn_s_getreg((3 << 11) | 20) & 0xFu; }
#define XB_SPIN(cond, bar) do { unsigned _sp = 0; while (cond) { __builtin_amdgcn_s_sleep(1); \
    if ((++_sp & 255u) == 0u) { if (xb_ld(&(bar)[XB_TMO])) break; if (_sp > XB_SPIN_CAP) { atomicAdd(&(bar)[XB_TMO], 1u); break; } } } } while (0)

struct XcdBarrier {
    unsigned* bar; unsigned x;
    volatile LAS unsigned* st;
};

__device__ __forceinline__ XcdBarrier xcd_barrier_post(unsigned* bar, volatile LAS unsigned* st) {
    XcdBarrier b; b.bar = bar; b.x = xb_xcc_id(); b.st = st;
    if (threadIdx.x == 0) (void)xb_add(&bar[XB_XCNT(b.x)], 1u);
    return b;
}
__device__ __forceinline__ void xcd_barrier_complete(unsigned* bar, unsigned x, unsigned& nloc, unsigned& nx) {
    const unsigned G = gridDim.x * gridDim.y * gridDim.z;
    unsigned sum, cnt, mine, sp = 0u;
    for (;;) {
        sum = 0u; cnt = 0u; mine = 0u;
#pragma unroll
        for (unsigned j = 0; j < 16; ++j) { const unsigned c = xb_ld(&bar[XB_XCNT(j)]); sum += c; cnt += (c > 0u) ? 1u : 0u; mine = (j == x) ? c : mine; }
        if (sum == G) break;
        __builtin_amdgcn_s_sleep(1);
        if ((++sp & 255u) == 0u) { if (xb_ld(&bar[XB_TMO])) break; if (sp > XB_SPIN_CAP) { atomicAdd(&bar[XB_TMO], 1u); break; } }
    }
    nloc = mine > 0u ? mine : 1u; nx = cnt > 0u ? cnt : 1u;
}

__device__ __forceinline__ void xcd_barrier(const XcdBarrier& b) {
    asm volatile("s_waitcnt vmcnt(0)" ::: "memory");
    __syncthreads();
    if (threadIdx.x == 0) {
        unsigned* bar = b.bar;
        __builtin_amdgcn_s_waitcnt(0);
        unsigned nloc = b.st[0], nx = b.st[1];
        if (nloc == 0u) { xcd_barrier_complete(bar, b.x, nloc, nx); b.st[0] = nloc; b.st[1] = nx; }
        const unsigned old = xb_add(&bar[XB_XSUB(b.x)], 1u);
        const unsigned gen = old / nloc;
        if (old + 1u == (gen + 1u) * nloc) {
            __builtin_amdgcn_fence(__ATOMIC_RELEASE, "agent");
            asm volatile("s_waitcnt vmcnt(0)" ::: "memory");
            const unsigned og = xb_add(&bar[XB_TOP], 1u);
            const unsigned tg = og / nx;
            if (og + 1u == (tg + 1u) * nx) xb_add(&bar[XB_TOPGEN], 1u);
            else XB_SPIN(xb_ld(&bar[XB_TOPGEN]) == tg, bar);
            __builtin_amdgcn_fence(__ATOMIC_ACQUIRE, "agent");
            xb_add(&bar[XB_XGEN(b.x)], 1u);
            asm volatile("s_waitcnt vmcnt(0)" ::: "memory");
        } else {
            XB_SPIN(xb_ld(&bar[XB_XGEN(b.x)]) == gen, bar);
            __builtin_amdgcn_fence(__ATOMIC_ACQUIRE, "agent");
            asm volatile("s_waitcnt vmcnt(0)" ::: "memory");
        }
    }
    __syncthreads();
}
struct Frame {
    LAS unsigned char* lds;
    unsigned char* ws;
    unsigned* ctl;
    int tid, lane, wave, vcu, G;
    const float* in[21]; float* out;
};
enum { I_X = 0, I_META, I_FOX_NORM, I_FOX_WIN, I_FOX_BF, I_FOX_QN, I_FOX_KN, I_FOX_WOUT, I_HG_NORM, I_HG_WIN, I_HG_BF, I_HG_LB, I_HG_ON, I_HG_WOUT,
       I_MOE_NORM, I_MOE_WGRP, I_MOE_BGRP, I_MOE_WRT, I_MOE_BRT, I_MOE_WUP, I_MOE_WDN };

__device__ __forceinline__ float wave_sum(float v) {
#pragma unroll
    for (int o = 1; o < 64; o <<= 1) v += __shfl_xor(v, o);
    return v;
}

struct TrItem { const float* W; bf16* WT; int ldn, K, k0, n0, orow0; const float* gain; };
__device__ __forceinline__ void tr_load(const TrItem& I, int lane, float (&v)[32]) {
#pragma unroll
    for (int i = 0; i < 32; ++i) { const int kk = 2 * i + (lane >> 5); v[i] = I.W[(size_t)(I.k0 + kk) * I.ldn + I.n0 + (lane & 31)] * (I.gain ? I.gain[I.k0 + kk] : 1.f); }
}
__device__ __forceinline__ void tr_store(const TrItem& I, int lane, const float (&v)[32], LAS float* scr) {
#pragma unroll
    for (int i = 0; i < 32; ++i) { const int kk = 2 * i + (lane >> 5); scr[kk * 33 + (lane & 31)] = v[i]; }
    asm volatile("s_waitcnt lgkmcnt(0)" ::: "memory");
    const int c = lane & 7;
#pragma unroll
    for (int j = 0; j < 4; ++j) { const int n = (lane >> 3) + 8 * j; const LAS float* s = scr + (8 * c) * 33 + n;
        v4u o; o.x = pk2(s[0 * 33], s[1 * 33]); o.y = pk2(s[2 * 33], s[3 * 33]); o.z = pk2(s[4 * 33], s[5 * 33]); o.w = pk2(s[6 * 33], s[7 * 33]);
        *(v4u*)(I.WT + (size_t)(I.orow0 + n) * I.K + I.k0 + 8 * c) = o; }
    asm volatile("s_waitcnt lgkmcnt(0)" ::: "memory");
}
__device__ __forceinline__ int perm_qkv(int n0) { const int tile = n0 >> 8, r = n0 & 255, wc = r >> 6, bj = (r >> 5) & 1; return (tile << 8) + 128 * bj + 32 * wc; }
__device__ __forceinline__ int perm_up(int n0) { const int bj = n0 >> 9, rem = n0 & 511, pn = rem >> 7, j = rem & 127; return 256 * pn + 128 * bj + j; }

__device__ __forceinline__ TrItem moe_item(const Frame& F, int r) {
    constexpr int I_UP1 = 16 * 32, I_UP = 64 * I_UP1, I_DN1 = 8 * 32;
    bf16* WUP = (bf16*)(F.ws + WS_WUP); bf16* WDN = (bf16*)(F.ws + WS_WDN);
    if (r < I_UP) { const int e = r / I_UP1, q = r % I_UP1, kb = q / 32, nb = q % 32;
        return TrItem{F.in[I_MOE_WUP] + (size_t)e * DM * DM, WUP + (size_t)e * DM * DM, DM, DM, 64 * kb, 32 * nb, perm_up(32 * nb), F.in[I_MOE_NORM] + (e >> 5) * DM}; }
    r -= I_UP; const int e = r / I_DN1, q = r % I_DN1, kb = q / 32, nb = q % 32;
    return TrItem{F.in[I_MOE_WDN] + (size_t)e * DEXP * DM, WDN + (size_t)e * DM * DEXP, DM, DEXP, 64 * kb, 32 * nb, 32 * nb, nullptr};
}
__device__ __forceinline__ TrItem dense_item(const Frame& F, int r) {
    constexpr int I_QKV = 16 * 96, I_FO = 16 * 32, I_HI = 16 * 128;
    if (r < I_QKV) { const int kb = r / 96, nb = r % 96; return TrItem{F.in[I_FOX_WIN], (bf16*)(F.ws + WS_WQKV), 3 * DM + FH, DM, 64 * kb, 32 * nb, perm_qkv(32 * nb), F.in[I_FOX_NORM]}; } r -= I_QKV;
    if (r < I_FO) { const int kb = r / 32, nb = r % 32; return TrItem{F.in[I_FOX_WOUT], (bf16*)(F.ws + WS_WFO), DM, DM, 64 * kb, 32 * nb, 32 * nb, nullptr}; } r -= I_FO;
    if (r < I_HI) { const int kb = r / 128, nb = r % 128; return TrItem{F.in[I_HG_WIN], (bf16*)(F.ws + WS_WHI), 4 * DM, DM, 64 * kb, 32 * nb, 32 * nb, F.in[I_HG_NORM]}; } r -= I_HI;
    { const int kb = r / 32, nb = r % 32; return TrItem{F.in[I_HG_WOUT], (bf16*)(F.ws + WS_WHO), DM, DM, 64 * kb, 32 * nb, 32 * nb, nullptr}; }
}
#define TR_PIPELINE(ITEM_FN, NITEMS_) do { LAS float* scr = (LAS float*)(F.lds + F.wave * 16384); const int NGW = F.G * 8; int it = F.vcu * 8 + F.wave; \
    if (it < (NITEMS_)) { TrItem cur = ITEM_FN(F, it); float va[32], vb[32]; tr_load(cur, F.lane, va); \
        for (;;) { { const int itn = it + NGW; TrItem nx = cur; __builtin_amdgcn_s_waitcnt(0x0F70); if (itn < (NITEMS_)) { nx = ITEM_FN(F, itn); tr_load(nx, F.lane, vb); } tr_store(cur, F.lane, va, scr); it = itn; cur = nx; if (it >= (NITEMS_)) break; } \
                   { const int itn = it + NGW; TrItem nx = cur; __builtin_amdgcn_s_waitcnt(0x0F70); if (itn < (NITEMS_)) { nx = ITEM_FN(F, itn); tr_load(nx, F.lane, va); } tr_store(cur, F.lane, vb, scr); it = itn; cur = nx; if (it >= (NITEMS_)) break; } } } } while (0)
__device__ __forceinline__ void p0_moe_weights(const Frame& F) { TR_PIPELINE(moe_item, 64 * 16 * 32 + 64 * 8 * 32); }
__device__ __forceinline__ void p0_prologue(const Frame& F) {
    TR_PIPELINE(dense_item, 16 * 96 + 16 * 32 + 16 * 128 + 16 * 32);
    const int gt = F.vcu * 512 + F.tid, NGT = F.G * 512;
    bf16* WSM = (bf16*)(F.ws + WS_WSM);
    for (int i = gt; i < 16 * 1024 + 2 * 48 * 1024; i += NGT) {
        float w; bf16* hi; bf16* lo;
        if (i < 16 * 1024) { const int n = i >> 10, k = i & 1023; w = F.in[I_FOX_WIN][(size_t)k * (3 * DM + FH) + 3 * DM + n]; hi = WSM + i; lo = WSM + 16384 + i; }
        else { const int j = i - 16 * 1024, l = j / (48 * 1024), q = j % (48 * 1024), n = q >> 10, k = q & 1023;
            w = n < 4 ? F.in[I_MOE_WGRP][((size_t)l * DM + k) * 4 + n] : (n < 36 ? F.in[I_MOE_WRT][((size_t)l * DM + k) * 32 + (n - 4)] : 0.f);
            hi = WSM + 32768 + (size_t)l * 98304 + q; lo = hi + 49152; }
        const unsigned h = f2bf(w); *hi = (bf16)h; *lo = (bf16)f2bf(w - bf2f(h));
    }
    for (int i = gt; i < 4 * NBATCH * (LP - LQ) * 128; i += NGT) { const int which = i / (NBATCH * (LP - LQ) * 128), j = i % (NBATCH * (LP - LQ) * 128), b = j / ((LP - LQ) * 128), q = j % ((LP - LQ) * 128);
        v4u* base = (v4u*)(F.ws + (which == 0 ? WS_H : which == 1 ? WS_Q : which == 2 ? WS_K : WS_V));
        base[((size_t)b * LP + LQ) * 128 + q] = (v4u){0u, 0u, 0u, 0u}; }
}

__device__ __forceinline__ void lds_row8g(const LAS float* p, float (&v)[8]) { const f32x4 a = *(const LAS f32x4*)p, c = *(const LAS f32x4*)(p + 4);
    v[0] = a.x; v[1] = a.y; v[2] = a.z; v[3] = a.w; v[4] = c.x; v[5] = c.y; v[6] = c.z; v[7] = c.w; }
template <int MODE> struct TRegs { f32x4 a[4], c[4]; v4u h[4]; v4u u1[4], u2[4]; float w1, w2; };
template <int MODE> struct TTok { v4u ta; v2u tb; };
template <int MODE> __device__ __forceinline__ void t_tok(const Frame& F, int it, TTok<MODE>& T) {
    if (MODE == 2) { const int r = F.lane & 15, b = it / NBLK16, t = (it % NBLK16) * 16 + r; const unsigned* TOK = (const unsigned*)(F.ws + WS_TOK) + ((size_t)b * LP + t) * 8;
        T.ta = *(const v4u*)TOK; T.tb = *(const v2u*)(TOK + 4); }
}
template <int MODE> __device__ __forceinline__ void t_load(const Frame& F, int it, const TTok<MODE>& T, TRegs<MODE>& R) {
    const int r = F.lane & 15, g = F.lane >> 4, w = F.wave, b = it / NBLK16, t = (it % NBLK16) * 16 + r; const size_t row = (size_t)b * LP + t;
    const bf16* H = (const bf16*)(F.ws + WS_H); const bf16* Y = (const bf16*)(F.ws + WS_XPAD);
    const float* src = (t < NMETA ? F.in[I_META] + (size_t)t * DM : F.in[I_X] + ((size_t)b * SEQ + (t - NMETA)) * DM);
    const bf16* y1 = nullptr; const bf16* y2 = nullptr;
    if (MODE == 2) { const unsigned wa = T.ta.y, wb = T.ta.z; R.w1 = __uint_as_float(wa); R.w2 = __uint_as_float(wb); y1 = Y + (size_t)T.tb.x * DM; y2 = Y + (size_t)T.tb.y * DM; }
#pragma unroll
    for (int ks = 0; ks < 4; ++ks) { const int k0 = 128 * w + 32 * ks + 8 * g;
        if (MODE == 0) { R.a[ks] = *(const f32x4*)(src + k0); R.c[ks] = *(const f32x4*)(src + k0 + 4); } else R.h[ks] = *(const v4u*)(H + row * DM + k0);
        if (MODE == 2) { R.u1[ks] = *(const v4u*)(y1 + k0); R.u2[ks] = *(const v4u*)(y2 + k0); } }
}
__device__ __forceinline__ void t_load1_asm(const Frame& F, int it, TRegs<1>& R) {
    const int r = F.lane & 15, g = F.lane >> 4, w = F.wave, b = it / NBLK16, t = (it % NBLK16) * 16 + r; const size_t row = (size_t)b * LP + t;
    const bf16* p = (const bf16*)(F.ws + WS_H) + row * DM + 128 * w + 8 * g;
    asm volatile("global_load_dwordx4 %0, %4, off\n\tglobal_load_dwordx4 %1, %4, off offset:64\n\tglobal_load_dwordx4 %2, %4, off offset:128\n\tglobal_load_dwordx4 %3, %4, off offset:192"
                 : "=&v"(R.h[0]), "=&v"(R.h[1]), "=&v"(R.h[2]), "=&v"(R.h[3]) : "v"(p) : "memory");
}
#define T_WAIT1(R, n) asm volatile("s_waitcnt vmcnt(" #n ")" : "+v"((R).h[0]), "+v"((R).h[1]), "+v"((R).h[2]), "+v"((R).h[3]) :: "memory")
template <int MODE, int NB, int POST, bool FINAL>
__device__ __forceinline__ void t_proc(const Frame& F, int it, int par, TRegs<MODE>& R, const bf16x8 (&wh)[NB > 0 ? NB : 1][4], const bf16x8 (&wl)[NB > 0 ? NB : 1][4], int layer) {
    const LAS float* gnl = (const LAS float*)(F.lds + 57344);
    const LAS float* bia = (const LAS float*)(F.lds + 61440);
    LAS float* ssq = (LAS float*)(F.lds);
    LAS float* lg = (LAS float*)(F.lds + 1024);
    LAS float* lgs = (LAS float*)(F.lds + 1024 + 49152);
    const int r = F.lane & 15, g = F.lane >> 4, w = F.wave;
    bf16* H = (bf16*)(F.ws + WS_H); unsigned* TOK = (unsigned*)(F.ws + WS_TOK);
    const int b = it / NBLK16, t0 = (it % NBLK16) * 16, t = t0 + r; const size_t row = (size_t)b * LP + t;
    float val[4][8]; float ss = 0.f;
#pragma unroll
    for (int ks = 0; ks < 4; ++ks) {
        const int k0 = 128 * w + 32 * ks + 8 * g;
        f32x4 a, c;
        if (MODE == 0) { a = R.a[ks]; c = R.c[ks]; } else { const v4u hh = R.h[ks]; a = (f32x4){bflo(hh.x), bfhi(hh.x), bflo(hh.y), bfhi(hh.y)}; c = (f32x4){bflo(hh.z), bfhi(hh.z), bflo(hh.w), bfhi(hh.w)}; }
        if (MODE == 2) { const v4u u1 = R.u1[ks], u2 = R.u2[ks]; const float w1 = R.w1, w2 = R.w2;
            a.x += w1 * bflo(u1.x) + w2 * bflo(u2.x); a.y += w1 * bfhi(u1.x) + w2 * bfhi(u2.x); a.z += w1 * bflo(u1.y) + w2 * bflo(u2.y); a.w += w1 * bfhi(u1.y) + w2 * bfhi(u2.y);
            c.x += w1 * bflo(u1.z) + w2 * bflo(u2.z); c.y += w1 * bfhi(u1.z) + w2 * bfhi(u2.z); c.z += w1 * bflo(u1.w) + w2 * bflo(u2.w); c.w += w1 * bfhi(u1.w) + w2 * bfhi(u2.w); }
        if (FINAL) { if (t >= NMETA) { float* o = F.out + ((size_t)b * SEQ + (t - NMETA)) * DM + k0; *(f32x4*)o = a; *(f32x4*)(o + 4) = c; } }
        else if (MODE != 1) { v4u hv; hv.x = pk2(a.x, a.y); hv.y = pk2(a.z, a.w); hv.z = pk2(c.x, c.y); hv.w = pk2(c.z, c.w); *(v4u*)(H + row * DM + k0) = hv;
            a = (f32x4){bflo(hv.x), bfhi(hv.x), bflo(hv.y), bfhi(hv.y)}; c = (f32x4){bflo(hv.z), bfhi(hv.z), bflo(hv.w), bfhi(hv.w)}; }
        val[ks][0] = a.x; val[ks][1] = a.y; val[ks][2] = a.z; val[ks][3] = a.w; val[ks][4] = c.x; val[ks][5] = c.y; val[ks][6] = c.z; val[ks][7] = c.w;
        ss += (a.x * a.x + a.y * a.y) + (a.z * a.z + a.w * a.w) + (c.x * c.x + c.y * c.y) + (c.z * c.z + c.w * c.w);
    }
    if (FINAL) return;
    if (NB > 0) {
        f32x4 acc[NB > 0 ? NB : 1];
#pragma unroll
        for (int nb = 0; nb < NB; ++nb) acc[nb] = (f32x4){0.f, 0.f, 0.f, 0.f};
#pragma unroll
        for (int ks = 0; ks < 4; ++ks) {
            float gk[8]; lds_row8g(gnl + 128 * w + 32 * ks + 8 * g, gk);
            v4u hp, lp;
#pragma unroll
            for (int j = 0; j < 4; ++j) { const float x0 = val[ks][2 * j] * gk[2 * j], x1 = val[ks][2 * j + 1] * gk[2 * j + 1]; const unsigned h = pk2(x0, x1);
                hp[j] = h; lp[j] = pk2(x0 - bflo(h), x1 - bfhi(h)); }
            const bf16x8 ah = __builtin_bit_cast(bf16x8, hp), al = __builtin_bit_cast(bf16x8, lp);
#pragma unroll
            for (int nb = 0; nb < NB; ++nb) {
                const bf16x8 bh = wh[nb][ks], bl = wl[nb][ks];
                acc[nb] = __builtin_amdgcn_mfma_f32_16x16x32_bf16(ah, bh, acc[nb], 0, 0, 0);
                acc[nb] = __builtin_amdgcn_mfma_f32_16x16x32_bf16(ah, bl, acc[nb], 0, 0, 0);
                acc[nb] = __builtin_amdgcn_mfma_f32_16x16x32_bf16(al, bh, acc[nb], 0, 0, 0);
            }
        }
#pragma unroll
        for (int nb = 0; nb < NB; ++nb)
#pragma unroll
            for (int q = 0; q < 4; ++q) lg[((par * 8 + w) * 16 + 4 * g + q) * 48 + 16 * nb + r] = acc[nb][q];
    }
    ss += __shfl_xor(ss, 16); ss += __shfl_xor(ss, 32);
    if (g == 0) ssq[par * 128 + w * 16 + r] = ss;
    __syncthreads();
    float tot = 0.f;
#pragma unroll
    for (int ww = 0; ww < 8; ++ww) tot += ssq[par * 128 + ww * 16 + r];
    const float rstd = __builtin_amdgcn_rsqf(tot * (1.f / DM) + EPS);
    if (w == 0 && g == 0) ((float*)(F.ws + WS_RSTD))[row] = rstd;
    if (POST == 1) {
        if (F.tid < 256) { const int rr = F.tid >> 4, n = F.tid & 15; float s = 0.f, tt = 0.f;
#pragma unroll
            for (int ww = 0; ww < 8; ++ww) { s += lg[((par * 8 + ww) * 16 + rr) * 48 + n]; tt += ssq[par * 128 + ww * 16 + rr]; }
            const float x = s * __builtin_amdgcn_rsqf(tt * (1.f / DM) + EPS) + bia[n];
            const float lf = (x >= 0.f) ? -log1pf(__expf(-x)) : x - log1pf(__expf(x));
            ((float*)(F.ws + WS_LFT))[(size_t)(b * FH + n) * LP + t0 + rr] = lf * LOG2E; }
    }
    if (POST == 2) {
        if (w == 0) {
#pragma unroll
            for (int q = 0; q < 12; ++q) { const int idx = F.lane + 64 * q, rr = idx / 48, n = idx % 48; float s = 0.f;
#pragma unroll
                for (int ww = 0; ww < 8; ++ww) s += lg[((par * 8 + ww) * 16 + rr) * 48 + n];
                lgs[par * 768 + idx] = s; }
            asm volatile("s_waitcnt lgkmcnt(0)" ::: "memory");
            __builtin_amdgcn_wave_barrier();
            if (F.lane < 16) {
                const LAS float* L = lgs + par * 768 + r * 48;
                const LAS float* bg = bia; const LAS float* br = bia + 4;
                float gl[4]; int gi = 0; float gm;
#pragma unroll
                for (int j = 0; j < 4; ++j) gl[j] = L[j] * rstd + bg[j];
                gm = gl[0];
#pragma unroll
                for (int j = 1; j < 4; ++j) if (gl[j] > gm) { gm = gl[j]; gi = j; }
                float gsum = 0.f;
#pragma unroll
                for (int j = 0; j < 4; ++j) gsum += __expf(gl[j] - gm);
                const float ggate = 1.f / gsum;
                float v1 = -3.0e38f, v2 = -3.0e38f; int i1 = 0, i2 = 0;
#pragma unroll
                for (int j = 0; j < 8; ++j) { const float e = L[4 + 8 * gi + j] * rstd + br[8 * gi + j];
                    if (e > v1) { v2 = v1; i2 = i1; v1 = e; i1 = j; } else if (e > v2) { v2 = e; i2 = j; } }
                const float ex = __expf(v2 - v1), p1 = 1.f / (1.f + ex);
                const int e1 = 8 * gi + i1, e2 = 8 * gi + i2;
                v4u ta; ta.x = (unsigned)e1 | ((unsigned)e2 << 8); ta.y = __builtin_bit_cast(unsigned, ggate * p1); ta.z = __builtin_bit_cast(unsigned, ggate * ex * p1); ta.w = __builtin_bit_cast(unsigned, rstd);
                *(v4u*)(TOK + row * 8) = ta;
                LAS unsigned* hist = (LAS unsigned*)(F.lds + 61440 + 256);
                __hip_atomic_fetch_add(hist + e1, 1u, __ATOMIC_RELAXED, __HIP_MEMORY_SCOPE_WORKGROUP);
                __hip_atomic_fetch_add(hist + e2, 1u, __ATOMIC_RELAXED, __HIP_MEMORY_SCOPE_WORKGROUP);
            }
        }
    }
}
template <int MODE, int NB, int POST, bool FINAL>
__device__ __forceinline__ void t_phase(const Frame& F, const float* __restrict__ gain, const bf16* __restrict__ wsm_hi, const bf16* __restrict__ wsm_lo, int layer) {
    constexpr int NIT = NBATCH * NBLK16;
    const int r = F.lane & 15, g = F.lane >> 4, w = F.wave;
    bf16x8 wh[NB > 0 ? NB : 1][4], wl[NB > 0 ? NB : 1][4];
    if (POST == 2) { int* SROW = (int*)(F.ws + WS_SROW); for (int i = F.vcu * 512 + F.tid; i < XPAD_ROWS; i += F.G * 512) SROW[i] = 0; }
    if (!FINAL) {
        LAS float* gnl = (LAS float*)(F.lds + 57344); LAS float* bia = (LAS float*)(F.lds + 61440);
        { const float g0 = gain[F.tid], g1 = gain[F.tid + 512]; gnl[F.tid] = g0; gnl[F.tid + 512] = g1; }
        if (POST == 1 && F.tid < 16) bia[F.tid] = F.in[I_FOX_BF][F.tid];
        if (POST == 2 && F.tid < 36) bia[F.tid] = F.tid < 4 ? F.in[I_MOE_BGRP][layer * 4 + F.tid] : F.in[I_MOE_BRT][layer * 32 + F.tid - 4];
        if (POST == 2 && F.tid < NEXP) ((LAS unsigned*)(F.lds + 61440 + 256))[F.tid] = 0u;
#pragma unroll
        for (int nb = 0; nb < NB; ++nb)
#pragma unroll
            for (int ks = 0; ks < 4; ++ks) { const int k0 = 128 * w + 32 * ks + 8 * g;
                wh[nb][ks] = *(const bf16x8*)(wsm_hi + (size_t)(16 * nb + r) * DM + k0); wl[nb][ks] = *(const bf16x8*)(wsm_lo + (size_t)(16 * nb + r) * DM + k0); }
        __syncthreads();
    }
    int it = blockIdx.x;
    if (MODE == 1 && !FINAL) {
        if (it < NIT) {
            TRegs<1> A, B; int par = 0;
            __builtin_amdgcn_s_waitcnt(0x0F70);
            t_load1_asm(F, it, A); if (it + F.G < NIT) t_load1_asm(F, it + F.G, B);
            for (;;) {
                { if (it + F.G < NIT) T_WAIT1(A, 4); else T_WAIT1(A, 0);
                  t_proc<MODE, NB, POST, FINAL>(F, it, par, (TRegs<MODE>&)A, wh, wl, layer); par ^= 1; if (it + 2 * F.G < NIT) t_load1_asm(F, it + 2 * F.G, A); it += F.G; if (it >= NIT) break; }
                { if (it + F.G < NIT) T_WAIT1(B, 4); else T_WAIT1(B, 0);
                  t_proc<MODE, NB, POST, FINAL>(F, it, par, (TRegs<MODE>&)B, wh, wl, layer); par ^= 1; if (it + 2 * F.G < NIT) t_load1_asm(F, it + 2 * F.G, B); it += F.G; if (it >= NIT) break; }
            }
        }
    } else if (it < NIT) {
        TRegs<MODE> A, B; TTok<MODE> T0, T1;
        t_tok<MODE>(F, it, T0); if (it + F.G < NIT) t_tok<MODE>(F, it + F.G, T1);
        t_load<MODE>(F, it, T0, A);
        int par = 0;
        for (;;) {
            { const int itn = it + F.G; __builtin_amdgcn_s_waitcnt(0x0F70); if (itn < NIT) { t_load<MODE>(F, itn, T1, B); if (itn + F.G < NIT) t_tok<MODE>(F, itn + F.G, T0); }
              t_proc<MODE, NB, POST, FINAL>(F, it, par, A, wh, wl, layer); par ^= 1; it = itn; if (it >= NIT) break; }
            { const int itn = it + F.G; __builtin_amdgcn_s_waitcnt(0x0F70); if (itn < NIT) { t_load<MODE>(F, itn, T0, A); if (itn + F.G < NIT) t_tok<MODE>(F, itn + F.G, T1); }
              t_proc<MODE, NB, POST, FINAL>(F, it, par, B, wh, wl, layer); par ^= 1; it = itn; if (it >= NIT) break; }
        }
    }
    __syncthreads();
    if (POST == 2 && F.tid < NEXP) { const unsigned hv = ((LAS unsigned*)(F.lds + 61440 + 256))[F.tid]; if (hv) __hip_atomic_fetch_add(F.ctl + CW_CNT + layer * 2048 + F.tid * 16, hv, RLX_AGENT); }
}
struct EpiQKV {
    static constexpr bool PERM = true, AFTER_DRAIN = false;
    bf16* Q; const float* gq; const float* gk; const LAS float* rstd;
    __device__ __forceinline__ void operator()(const pg8::f32x4 (&acc)[2][2][4][2], const pg8::Unit& u, int wr, int wc, int fr, int fq) const {
        const int type = u.pn >> 2, head = (u.pn & 3) * 4 + wc;
        bf16* dst = Q + (size_t)type * ((WS_K - WS_Q) / 2);
        float gs[2][8];
        if (type < 2) {
#pragma unroll
            for (int bj = 0; bj < 2; ++bj)
#pragma unroll
                for (int j = 0; j < 8; ++j) { const float a = gq[32 * bj + 8 * fq + j] * C2, b = gk[32 * bj + 8 * fq + j]; gs[bj][j] = type == 0 ? a : b; } }
        const int row0 = u.pm * 256 + wr * 64 + fr;
#pragma unroll
        for (int ai = 0; ai < 2; ++ai)
#pragma unroll
            for (int m = 0; m < 4; ++m) {
                const size_t row = (size_t)(row0 + ai * 128 + m * 16);
                float sc = rstd[u.ord * 256 + wr * 64 + fr + ai * 128 + m * 16];
                if (type < 2) { float ss = 0.f;
#pragma unroll
                    for (int bj = 0; bj < 2; ++bj)
#pragma unroll
                        for (int n = 0; n < 2; ++n) { const pg8::f32x4 x = acc[ai][bj][m][n]; ss += (x[0] * x[0] + x[1] * x[1]) + (x[2] * x[2] + x[3] * x[3]); }
                    ss += __shfl_xor(ss, 16); ss += __shfl_xor(ss, 32);
                    sc = sc * __builtin_amdgcn_rsqf(sc * sc * ss * (1.f / FD) + EPS); }
#pragma unroll
                for (int bj = 0; bj < 2; ++bj) {
                    pg8::f32x4 v0 = acc[ai][bj][m][0], v1 = acc[ai][bj][m][1];
                    if (type < 2) { v0[0] *= sc * gs[bj][0]; v0[1] *= sc * gs[bj][1]; v0[2] *= sc * gs[bj][2]; v0[3] *= sc * gs[bj][3];
                                    v1[0] *= sc * gs[bj][4]; v1[1] *= sc * gs[bj][5]; v1[2] *= sc * gs[bj][6]; v1[3] *= sc * gs[bj][7]; }
                    else { v0 *= sc; v1 *= sc; }
                    v4u o; o.x = pk2(v0[0], v0[1]); o.y = pk2(v0[2], v0[3]); o.z = pk2(v1[0], v1[1]); o.w = pk2(v1[2], v1[3]);
                    *(v4u*)(dst + row * DM + head * FD + 32 * bj + 8 * fq) = o;
                }
            }
    }
};
struct EpiResid {
    static constexpr bool PERM = true, AFTER_DRAIN = false;
    bf16* H;
    __device__ __forceinline__ void operator()(const pg8::f32x4 (&acc)[2][2][4][2], const pg8::Unit& u, int wr, int wc, int fr, int fq) const {
        const int row0 = u.pm * 256 + wr * 64 + fr, col0 = u.pn * 256 + 32 * wc + 8 * fq;
#pragma unroll
        for (int ai = 0; ai < 2; ++ai)
#pragma unroll
            for (int m = 0; m < 4; ++m)
#pragma unroll
                for (int bj = 0; bj < 2; ++bj) { bf16* p = H + (size_t)(row0 + ai * 128 + m * 16) * DM + col0 + 128 * bj;
                    const v4u hh = *(const v4u*)p; const pg8::f32x4 x0 = acc[ai][bj][m][0], x1 = acc[ai][bj][m][1];
                    v4u o; o.x = pk2(bflo(hh.x) + x0[0], bfhi(hh.x) + x0[1]); o.y = pk2(bflo(hh.y) + x0[2], bfhi(hh.y) + x0[3]);
                    o.z = pk2(bflo(hh.z) + x1[0], bfhi(hh.z) + x1[1]); o.w = pk2(bflo(hh.w) + x1[2], bfhi(hh.w) + x1[3]);
                    *(v4u*)p = o; }
    }
};
struct EpiResidX {
    static constexpr bool PERM = true, AFTER_DRAIN = false;
    bf16* H; const float* x; const float* meta;
    __device__ __forceinline__ void operator()(const pg8::f32x4 (&acc)[2][2][4][2], const pg8::Unit& u, int wr, int wc, int fr, int fq) const {
        const int row0 = u.pm * 256 + wr * 64 + fr, col0 = u.pn * 256 + 32 * wc + 8 * fq;
#pragma unroll
        for (int ai = 0; ai < 2; ++ai)
#pragma unroll
            for (int m = 0; m < 4; ++m) { const int row = row0 + ai * 128 + m * 16, b = row / LP, t = row - b * LP;
                if (t < LQ) { const float* src = (t < NMETA ? meta + (size_t)t * DM : x + ((size_t)b * SEQ + (t - NMETA)) * DM) + col0;
#pragma unroll
                    for (int bj = 0; bj < 2; ++bj) { bf16* p = H + (size_t)row * DM + col0 + 128 * bj;
                        f32x4 a = *(const f32x4*)(src + 128 * bj), c = *(const f32x4*)(src + 128 * bj + 4);
                        a += acc[ai][bj][m][0]; c += acc[ai][bj][m][1];
                        v4u o; o.x = pk2(a.x, a.y); o.y = pk2(a.z, a.w); o.z = pk2(c.x, c.y); o.w = pk2(c.z, c.w);
                        *(v4u*)p = o; } } }
    }
};
struct EpiUp {
    static constexpr bool PERM = true, AFTER_DRAIN = false;
    bf16* ACT; const LAS float* rs;
    __device__ __forceinline__ void operator()(const pg8::f32x4 (&acc)[2][2][4][2], const pg8::Unit& u, int wr, int wc, int fr, int fq) const {
        const int row0 = u.pm * 256 + wr * 64 + fr, col0 = (u.pn & 3) * 128 + 32 * wc + 8 * fq;
#pragma unroll
        for (int ai = 0; ai < 2; ++ai)
#pragma unroll
            for (int m = 0; m < 4; ++m) {
                const float sc = rs[u.ord * 256 + wr * 64 + fr + ai * 128 + m * 16];
                const pg8::f32x4 a0 = acc[ai][0][m][0] * sc, a1 = acc[ai][0][m][1] * sc, u0 = acc[ai][1][m][0] * sc, u1 = acc[ai][1][m][1] * sc;
                v4u o; o.x = pk2(silu(a0[0]) * u0[0], silu(a0[1]) * u0[1]); o.y = pk2(silu(a0[2]) * u0[2], silu(a0[3]) * u0[3]);
                o.z = pk2(silu(a1[0]) * u1[0], silu(a1[1]) * u1[1]); o.w = pk2(silu(a1[2]) * u1[2], silu(a1[3]) * u1[3]);
                *(v4u*)(ACT + (size_t)(row0 + ai * 128 + m * 16) * DEXP + col0) = o;
            }
    }
};
struct EpiDown {
    static constexpr bool PERM = true, AFTER_DRAIN = false;
    bf16* Y;
    __device__ __forceinline__ void operator()(const pg8::f32x4 (&acc)[2][2][4][2], const pg8::Unit& u, int wr, int wc, int fr, int fq) const {
        const int row0 = u.pm * 256 + wr * 64 + fr, col0 = (u.pn & 3) * 256 + 32 * wc + 8 * fq;
#pragma unroll
        for (int ai = 0; ai < 2; ++ai)
#pragma unroll
            for (int m = 0; m < 4; ++m)
#pragma unroll
                for (int bj = 0; bj < 2; ++bj) { const pg8::f32x4 v0 = acc[ai][bj][m][0], v1 = acc[ai][bj][m][1];
                    v4u o; o.x = pk2(v0[0], v0[1]); o.y = pk2(v0[2], v0[3]); o.z = pk2(v1[0], v1[1]); o.w = pk2(v1[2], v1[3]);
                    *(v4u*)(Y + (size_t)(row0 + ai * 128 + m * 16) * DM + col0 + 128 * bj) = o; }
    }
};
struct EpiHgIn {
    static constexpr bool PERM = true, AFTER_DRAIN = false;
    bf16* QS; float* LOGF; const float* bfv; const float* lbl; const LAS float* rstd;
    __device__ __forceinline__ void operator()(const pg8::f32x4 (&acc)[2][2][4][2], const pg8::Unit& u, int wr, int wc, int fr, int fq) const {
        const int type = u.pn >> 2, row0 = u.pm * 256 + wr * 64 + fr, col0 = (u.pn & 3) * 256 + 32 * wc + 8 * fq;
        float bias[2][8], lb[2][8];
        if (type == 1) {
#pragma unroll
            for (int bj = 0; bj < 2; ++bj)
#pragma unroll
                for (int j = 0; j < 8; ++j) { const int c = col0 + 128 * bj + j; bias[bj][j] = bfv[c]; lb[bj][j] = frcp(1.f + fexp(lbl[c] - lbl[DM + c])); }
        }
        bf16* dst = QS + (size_t)(type == 0 ? 0 : (type == 2 ? 2 : 1)) * ((WS_K - WS_Q) / 2);
#pragma unroll
        for (int ai = 0; ai < 2; ++ai)
#pragma unroll
            for (int m = 0; m < 4; ++m)
#pragma unroll
                for (int bj = 0; bj < 2; ++bj) {
                    const size_t off = (size_t)(row0 + ai * 128 + m * 16) * DM + col0 + 128 * bj;
                    float v[8]; const float sc = rstd[u.ord * 256 + wr * 64 + fr + ai * 128 + m * 16];
#pragma unroll
                    for (int j = 0; j < 4; ++j) { v[j] = acc[ai][bj][m][0][j] * sc; v[4 + j] = acc[ai][bj][m][1][j] * sc; }
                    if (type == 1) {
#pragma unroll
                        for (int j = 0; j < 8; ++j) { const float sg = frcp(1.f + fexp(-(v[j] + bias[bj][j]))); const float f = lb[bj][j] + (1.f - lb[bj][j]) * sg; v[j] = __logf(f); }
                        *(f32x4*)(LOGF + off) = (f32x4){v[0], v[1], v[2], v[3]}; *(f32x4*)(LOGF + off + 4) = (f32x4){v[4], v[5], v[6], v[7]};
                    } else {
                        if (type != 2) {
#pragma unroll
                            for (int j = 0; j < 8; ++j) v[j] = silu(v[j]); }
                        v4u o; o.x = pk2(v[0], v[1]); o.y = pk2(v[2], v[3]); o.z = pk2(v[4], v[5]); o.w = pk2(v[6], v[7]);
                        *(v4u*)(dst + off) = o;
                    }
                }
    }
};

__device__ __forceinline__ void fox_scan(const Frame& F) {
    if (blockIdx.x >= NBATCH * FH) return;
    LAS float* buf = (LAS float*)F.lds;
    LAS float* wt = (LAS float*)(F.lds + 69632);
    const float* src = (const float*)(F.ws + WS_LFT) + (size_t)blockIdx.x * LP; float* dst = (float*)(F.ws + WS_CC) + (size_t)blockIdx.x * LP;
    { float v[33];
#pragma unroll
        for (int j = 0; j < 33; ++j) { const int i = F.tid + 512 * j; v[j] = (i < LQ) ? src[i] : 0.f; }
#pragma unroll
        for (int j = 0; j < 33; ++j) { const int i = F.tid + 512 * j; if (i < LP) buf[i] = v[j]; } }
    __syncthreads();
    constexpr int PER = 33;
    const int s0 = F.tid * PER;
    float part = 0.f;
    for (int j = 0; j < PER; ++j) { const int i = s0 + j; if (i < LP) part += buf[i]; }
    float inc = part;
#pragma unroll
    for (int o = 1; o < 64; o <<= 1) { const float n = __shfl_up(inc, o); if (F.lane >= o) inc += n; }
    if (F.lane == 63) wt[F.wave] = inc;
    __syncthreads();
    float base = inc - part;
    for (int ww = 0; ww < F.wave; ++ww) base += wt[ww];
    float run = base;
    for (int j = 0; j < PER; ++j) { const int i = s0 + j; if (i < LP) { run += buf[i]; buf[i] = run; } }
    __syncthreads();
    for (int i = F.tid; i < LP; i += 512) dst[i] = buf[i];
    __syncthreads();
}

constexpr int AT_SUB = 17536;
constexpr int AT_BUF = 2 * AT_SUB;
constexpr int AT_WS = 2 * AT_BUF;
constexpr int AT_MISC = AT_WS + 2048;
__device__ __forceinline__ int crow(int r, int hi) { return (r & 3) + 8 * (r >> 2) + 4 * hi; }
typedef short v4i16_t __attribute__((ext_vector_type(4)));
__device__ __forceinline__ bf16x4 vtr(const LAS unsigned char* p) { return __builtin_bit_cast(bf16x4, __builtin_amdgcn_ds_read_tr16_b64_v4i16((LAS v4i16_t*)p)); }

__device__ __forceinline__ void attn_tile(const LAS unsigned char* B, int t, int wrow0, int lane, int r32, int hi, const bf16x8& qe, float cw0, float thr, const bf16x8 (&qr)[4], float& l, f32x16 (&o)[2]) {
    if (64 * t <= wrow0 + 31 && cw0 - *(const LAS float*)(B + 17408) >= thr) {
        f32x16 p0, p1;
#pragma unroll
        for (int r = 0; r < 16; ++r) { p0[r] = 0.f; p1[r] = 0.f; }
        { const bf16x8 e0 = *(const LAS bf16x8*)(B + 16384 + r32 * 16), e1 = *(const LAS bf16x8*)(B + 16384 + 512 + r32 * 16);
            p0 = __builtin_amdgcn_mfma_f32_32x32x16_bf16(e0, qe, p0, 0, 0, 0);
            p1 = __builtin_amdgcn_mfma_f32_32x32x16_bf16(e1, qe, p1, 0, 0, 0); }
#pragma unroll
        for (int d0 = 0; d0 < 4; ++d0) {
            const bf16x8 a0 = *(const LAS bf16x8*)(B + (2 * d0 + hi) * 1024 + r32 * 16), a1 = *(const LAS bf16x8*)(B + (2 * d0 + hi) * 1024 + 512 + r32 * 16);
            p0 = __builtin_amdgcn_mfma_f32_32x32x16_bf16(a0, qr[d0], p0, 0, 0, 0);
            p1 = __builtin_amdgcn_mfma_f32_32x32x16_bf16(a1, qr[d0], p1, 0, 0, 0);
        }
        if (64 * t + 63 > wrow0) {
            const int qpos = wrow0 + r32, kb = 64 * t + 4 * hi;
#pragma unroll
            for (int r = 0; r < 16; ++r) { const int kv = kb + (r & 3) + 8 * (r >> 2); if (kv > qpos) p0[r] = -1.0e30f; if (kv + 32 > qpos) p1[r] = -1.0e30f; }
        }
        float sacc = 0.f;
#pragma unroll
        for (int r = 0; r < 16; ++r) { p0[r] = fexp2(p0[r]); p1[r] = fexp2(p1[r]); sacc += p0[r] + p1[r]; }
        l += sacc;
        bf16x8 pa[4];
#pragma unroll
        for (int s = 0; s < 4; ++s) { const f32x16& P = (s < 2) ? p0 : p1; const int h8 = 8 * (s & 1);
            v4u pk; pk.x = pk2(P[h8 + 0], P[h8 + 1]); pk.y = pk2(P[h8 + 2], P[h8 + 3]); pk.z = pk2(P[h8 + 4], P[h8 + 5]); pk.w = pk2(P[h8 + 6], P[h8 + 7]);
            pa[s] = __builtin_bit_cast(bf16x8, pk); }
        const LAS unsigned char* vp = B + 8192 + ((lane >> 4) & 1) * 32 + (lane & 3) * 8 + (4 * hi + ((lane & 15) >> 2)) * 64;
#pragma unroll
        for (int dq = 0; dq < 2; ++dq)
#pragma unroll
            for (int s = 0; s < 4; ++s) { const bf16x4 lo = vtr(vp + dq * 4096 + s * 1024), hh = vtr(vp + dq * 4096 + s * 1024 + 512);
                const bf16x8 vf = (bf16x8){lo[0], lo[1], lo[2], lo[3], hh[0], hh[1], hh[2], hh[3]};
                o[dq] = __builtin_amdgcn_mfma_f32_32x32x16_bf16(pa[s], vf, o[dq], 0, 0, 0); }
    }
}
__device__ __forceinline__ void attn_unit(const Frame& F, int b, int hd, int qb, float thr, float bq) {
    const int tid = F.tid, lane = F.lane, w = F.wave, r32 = lane & 31, hi = lane >> 5;
    const size_t rowb = (size_t)b * LP; const int q0 = qb * 256;
    const bf16* Qh = (const bf16*)(F.ws + WS_Q) + rowb * DM + hd * FD; const bf16* Kh = (const bf16*)(F.ws + WS_K) + rowb * DM + hd * FD; const bf16* Vh = (const bf16*)(F.ws + WS_V) + rowb * DM + hd * FD;
    bf16* Oh = (bf16*)(F.ws + WS_Q) + rowb * DM + hd * FD;
    const float* Cs = (const float*)(F.ws + WS_CC) + (size_t)(b * FH + hd) * LP;
    LAS unsigned char* L = F.lds; LAS float* wsf = (LAS float*)(L + AT_WS) + w * 64; LAS int* misc = (LAS int*)(L + AT_MISC);
    const int t_hi = (qb == 64) ? 256 : 4 * qb + 3;
    if (tid == 0) misc[0] = t_hi;
    __syncthreads();
    { const float ci0 = Cs[q0]; if (tid <= t_hi) { if (ci0 - Cs[64 * tid + 63] >= thr) __hip_atomic_fetch_min(misc, tid, __ATOMIC_RELAXED, __HIP_MEMORY_SCOPE_WORKGROUP); } }
    __syncthreads();
    const int t_lo = misc[0];
    bf16x8 qr[4];
#pragma unroll
    for (int d0 = 0; d0 < 4; ++d0) qr[d0] = *(const bf16x8*)(Qh + (size_t)(q0 + 32 * w + r32) * DM + 16 * d0 + 8 * hi);
    const int wrow0 = q0 + 32 * w;
    const float cq = Cs[wrow0 + r32], cqb = cq - bq, cw0 = __shfl(cq, 0);
    bf16x8 qe;
    { const unsigned h = f2bf(cqb); const float r1 = cqb - bf2f(h); const unsigned m = f2bf(r1); const unsigned lo = f2bf(r1 - bf2f(m));
        const v4u qv = hi ? (v4u){0u, 0u, 0u, 0u} : (v4u){0x3F803F80u, 0x3F80u | (h << 16), m | (lo << 16), 0u}; qe = __builtin_bit_cast(bf16x8, qv); }
    float l = 0.f; f32x16 o[2];
#pragma unroll
    for (int r = 0; r < 16; ++r) { o[0][r] = 0.f; o[1][r] = 0.f; }
    const int skv = tid >> 3, sc = tid & 7;
    const bf16* ksrc = Kh + (size_t)skv * DM + 8 * sc; const bf16* vsrc = Vh + (size_t)skv * DM + 8 * sc;
    const int kdst = sc * 1024 + skv * 16, vdst = 8192 + (sc >> 2) * 4096 + skv * 64 + (sc & 3) * 16;
#define AT_LOAD(tt) do { k0_ = *(const v4u*)(ksrc + (size_t)(tt) * 64 * DM); v0_ = *(const v4u*)(vsrc + (size_t)(tt) * 64 * DM); k1_ = *(const v4u*)(ksrc + (size_t)((tt) + 1) * 64 * DM); v1_ = *(const v4u*)(vsrc + (size_t)((tt) + 1) * 64 * DM); \
        if (tid < 128) c_ = Cs[64 * (tt) + tid]; } while (0)
#define AT_STORE(bufo) do { LAS unsigned char* Bn_ = L + (bufo) * AT_BUF; *(LAS v4u*)(Bn_ + kdst) = k0_; *(LAS v4u*)(Bn_ + vdst) = v0_; *(LAS v4u*)(Bn_ + AT_SUB + kdst) = k1_; *(LAS v4u*)(Bn_ + AT_SUB + vdst) = v1_; \
        if (tid < 128) { LAS unsigned char* ce_ = Bn_ + (tid >> 6) * AT_SUB + 16384; const float nc_ = -c_; const unsigned h_ = f2bf(nc_); const float r1_ = nc_ - bf2f(h_); const unsigned m_ = f2bf(r1_); const unsigned l_ = f2bf(r1_ - bf2f(m_)); \
            *(LAS v4u*)(ce_ + 16 * (tid & 63)) = (v4u){h_ | (m_ << 16), l_ | 0x3F800000u, 0x3F803F80u, 0u}; if ((tid & 63) == 63) *(LAS float*)(ce_ + 1024) = c_; } } while (0)
    v4u k0_, v0_, k1_, v1_; float c_ = 0.f;
    const int p_hi = t_hi >> 1, p_lo = t_lo >> 1;
    AT_LOAD(2 * p_hi); AT_STORE(0);
    if (p_hi > p_lo) AT_LOAD(2 * p_hi - 2);
    __syncthreads();
    int cur = 0;
    const bool live = wrow0 < (qb == 64 ? LQ : 0x7fffffff);
    for (int pp = p_hi; pp >= p_lo; --pp) {
        const LAS unsigned char* B = L + cur * AT_BUF;
        if (live) { attn_tile(B + AT_SUB, 2 * pp + 1, wrow0, lane, r32, hi, qe, cw0, thr, qr, l, o); attn_tile(B, 2 * pp, wrow0, lane, r32, hi, qe, cw0, thr, qr, l, o); }
        if (pp > p_lo) { AT_STORE(cur ^ 1); if (pp - 1 > p_lo) AT_LOAD(2 * pp - 4); }
        __syncthreads(); cur ^= 1;
    }
#undef AT_LOAD
#undef AT_STORE
    { auto rr = __builtin_amdgcn_permlane32_swap(__float_as_uint(l), __float_as_uint(l), false, false); l = __uint_as_float(rr[0]) + __uint_as_float(rr[1]); }
    if (hi == 0) wsf[32 + r32] = l;
    asm volatile("s_waitcnt lgkmcnt(0)" ::: "memory");
    __builtin_amdgcn_wave_barrier();
#pragma unroll
    for (int rq = 0; rq < 4; ++rq) { const f32x4 lv = *(const LAS f32x4*)(wsf + 32 + 8 * rq + 4 * hi);
#pragma unroll
        for (int i = 0; i < 4; ++i) { const int r = 4 * rq + i; const float rl = frcp(lv[i]); bf16* op = Oh + (size_t)(wrow0 + crow(r, hi)) * DM + r32;
            op[0] = (bf16)f2bf(o[0][r] * rl); op[32] = (bf16)f2bf(o[1][r] * rl); } }
    __syncthreads();
}
__device__ __forceinline__ void attn_phase(const Frame& F) {
    float gq = fabsf(F.in[I_FOX_QN][F.lane]), gk = fabsf(F.in[I_FOX_KN][F.lane]);
#pragma unroll
    for (int o = 1; o < 64; o <<= 1) { gq = fmaxf(gq, __shfl_xor(gq, o)); gk = fmaxf(gk, __shfl_xor(gk, o)); }
    const float bq = 1.01f * C2 * FD * gq * gk, thr = -SKIP_T;
    for (int i = 0;; ++i) {
        const int id = i * F.G + F.vcu; if (id >= 65 * NBATCH * FH) break;
        int bh, qb; if (id < 64 * NBATCH * FH) { bh = id >> 6; qb = 63 - (id & 63); } else { bh = id - 64 * NBATCH * FH; qb = 64; }
        attn_unit(F, bh >> 4, bh & 15, qb, thr, bq);
    }
}
struct MainOrder {
    pg8::StaticOrder S;
    __device__ __forceinline__ void init(int N, int G, int c) { S.init(128 * 256, N, G, c); }
    __device__ __forceinline__ bool next(int i, pg8::Unit& u) const { if (!S.next(i, u)) return false; u.pm += (u.pm >= 64) ? 1 : 0; return true; }
    __device__ __forceinline__ void a_ready(const pg8::Unit&) const {}
    __device__ __forceinline__ void done(const pg8::Unit&) const {}
};
__device__ __forceinline__ int perm_qkv_row(int n) { return (n & ~255) + 128 * ((n >> 5) & 1) + 32 * ((n >> 6) & 3) + (n & 31); }
template <int KIND  >
__device__ __forceinline__ void skinny_gemm(const Frame& F, const bf16* __restrict__ A, const bf16* __restrict__ Bt, int N) {
    const int ntask = 2 * (N / 64), task = (int)blockIdx.x - (KIND == 0 ? 32 : 0);
    if (task < 0 || task >= ntask) return;
    const int b = task & 1, cg = task >> 1, i16 = F.lane & 15, g = F.lane >> 4;
    const size_t row0 = (size_t)b * LP + SEQ;
    const bf16* ap = A + (row0 + i16) * DM + 8 * g;
    const bf16* bp[4];
#pragma unroll
    for (int nb = 0; nb < 4; ++nb) { const int n = 64 * cg + 16 * nb + i16; bp[nb] = Bt + (size_t)(KIND == 0 ? perm_qkv_row(n) : n) * DM + 8 * g; }
    f32x4 acc[4];
#pragma unroll
    for (int nb = 0; nb < 4; ++nb) acc[nb] = (f32x4){0.f, 0.f, 0.f, 0.f};
#pragma unroll
    for (int kk = 0; kk < 4; ++kk) { const int ks = 4 * F.wave + kk; const bf16x8 af = *(const bf16x8*)(ap + 32 * ks);
#pragma unroll
        for (int nb = 0; nb < 4; ++nb) acc[nb] = __builtin_amdgcn_mfma_f32_16x16x32_bf16(af, *(const bf16x8*)(bp[nb] + 32 * ks), acc[nb], 0, 0, 0); }
    { LAS f32x4* red = (LAS f32x4*)F.lds;
#pragma unroll
        for (int nb = 0; nb < 4; ++nb) red[(F.wave * 4 + nb) * 64 + F.lane] = acc[nb];
        __syncthreads();
        if (F.wave == 0) {
#pragma unroll
            for (int nb = 0; nb < 4; ++nb) { f32x4 s = red[nb * 64 + F.lane];
#pragma unroll
                for (int ww = 1; ww < 8; ++ww) s += red[(ww * 4 + nb) * 64 + F.lane];
                acc[nb] = s; } }
        __syncthreads();
        if (F.wave != 0) return; }
    unsigned char* ws = F.ws;
    if (KIND == 0 || KIND == 3) { const float* RSTD = (const float*)(ws + WS_RSTD);
#pragma unroll
        for (int r = 0; r < 4; ++r) { const float sc = RSTD[row0 + 4 * g + r];
#pragma unroll
            for (int nb = 0; nb < 4; ++nb) acc[nb][r] *= sc; } }
    if (KIND == 0) {
        const int type = cg >> 4, head = cg & 15; bf16* dst = (bf16*)(ws + WS_Q) + (size_t)type * ((WS_K - WS_Q) / 2);
#pragma unroll
        for (int r = 0; r < 4; ++r) { float sc = 1.f;
            if (type < 2) { float ss = acc[0][r] * acc[0][r] + acc[1][r] * acc[1][r] + acc[2][r] * acc[2][r] + acc[3][r] * acc[3][r];
                ss += __shfl_xor(ss, 1); ss += __shfl_xor(ss, 2); ss += __shfl_xor(ss, 4); ss += __shfl_xor(ss, 8);
                sc = __builtin_amdgcn_rsqf(ss * (1.f / FD) + EPS); }
#pragma unroll
            for (int nb = 0; nb < 4; ++nb) { const int d = 16 * nb + i16; float v = acc[nb][r];
                if (type < 2) { const float gq = F.in[I_FOX_QN][d] * C2, gk = F.in[I_FOX_KN][d]; v *= sc * (type == 0 ? gq : gk); }
                dst[(row0 + 4 * g + r) * DM + head * FD + d] = (bf16)f2bf(v); } }
    } else if (KIND == 1 || KIND == 2) {
        bf16* H = (bf16*)(ws + WS_H);
#pragma unroll
        for (int r = 0; r < 4; ++r)
#pragma unroll
            for (int nb = 0; nb < 4; ++nb) { const int c = 64 * cg + 16 * nb + i16; const size_t row = row0 + 4 * g + r;
                const float base = bf2f(H[row * DM + c]);
                H[row * DM + c] = (bf16)f2bf(base + acc[nb][r]); }
    } else {
        const int type = cg >> 4; bf16* dst = (bf16*)(ws + WS_Q) + (size_t)(type == 0 ? 0 : (type == 2 ? 2 : 1)) * ((WS_K - WS_Q) / 2); float* LOGF = (float*)(ws + WS_LOGF);
#pragma unroll
        for (int nb = 0; nb < 4; ++nb) { const int c = 64 * (cg & 15) + 16 * nb + i16;
            float bias = 0.f, lb = 0.f;
            if (type == 1) { bias = F.in[I_HG_BF][c]; lb = frcp(1.f + fexp(F.in[I_HG_LB][c] - F.in[I_HG_LB][DM + c])); }
#pragma unroll
            for (int r = 0; r < 4; ++r) { const size_t off = (row0 + 4 * g + r) * DM + c; const float v = acc[nb][r];
                if (type == 1) { const float sg = frcp(1.f + fexp(-(v + bias))); LOGF[off] = __logf(lb + (1.f - lb) * sg); }
                else dst[off] = (bf16)f2bf(type == 2 ? v : silu(v)); } }
    }
}
constexpr int MOE_PSTART = MISC_OFF + 64, MOE_TEXP = MISC_OFF + 256, MOE_NTILE = MISC_OFF + 60;
__device__ __forceinline__ void moe_tables(const Frame& F, int layer) {
    LAS int* pstart = (LAS int*)(F.lds + MOE_PSTART); LAS int* texp = (LAS int*)(F.lds + MOE_TEXP); LAS int* ntile = (LAS int*)(F.lds + MOE_NTILE);
    __syncthreads();
    if (F.tid < NEXP) { const unsigned c = __hip_atomic_load(F.ctl + CW_CNT + layer * 2048 + F.tid * 16, RLX_AGENT); pstart[F.tid + 1] = (int)((c + 255u) >> 8) << 8; }
    __syncthreads();
    if (F.tid == 0) { int acc = 0; pstart[0] = 0;
        for (int e = 0; e < NEXP; ++e) { acc += pstart[e + 1]; pstart[e + 1] = acc; }
        ntile[0] = acc >> 8; }
    __syncthreads();
    const int nt = ntile[0];
    for (int t = F.tid; t < nt && t < XPAD_TILES; t += 512) { int e = 0;
        for (int j = 1; j < NEXP; ++j) e += (pstart[j] <= 256 * t) ? 1 : 0;
        texp[t] = e; }
    __syncthreads();
}
__device__ __forceinline__ void moe_gather(const Frame& F, int layer) {
    moe_tables(F, layer);
    const LAS int* pstart = (const LAS int*)(F.lds + MOE_PSTART);
    LAS unsigned* lh = (LAS unsigned*)F.lds; LAS unsigned* lbase = lh + 32;
    unsigned* TOK = (unsigned*)(F.ws + WS_TOK); int* SROW = (int*)(F.ws + WS_SROW); float* RS = (float*)(F.ws + WS_RS);
    if (F.tid < NEXP) lh[F.tid] = 0u;
    __syncthreads();
    const int i = F.vcu * 512 + F.tid; const bool act = i < NBATCH * LQ;
    int e1 = 0, e2 = 0; unsigned s1 = 0, s2 = 0; size_t row = 0; float rst = 0.f;
    if (act) { const int b = i / LQ, t = i - b * LQ; row = (size_t)b * LP + t;
        const unsigned ee = TOK[row * 8]; e1 = ee & 255; e2 = (ee >> 8) & 255; rst = __uint_as_float(TOK[row * 8 + 3]);
        s1 = __hip_atomic_fetch_add(lh + e1, 1u, __ATOMIC_RELAXED, __HIP_MEMORY_SCOPE_WORKGROUP);
        s2 = __hip_atomic_fetch_add(lh + e2, 1u, __ATOMIC_RELAXED, __HIP_MEMORY_SCOPE_WORKGROUP); }
    __syncthreads();
    if (F.tid < NEXP) { const unsigned n = lh[F.tid]; lbase[F.tid] = n ? __hip_atomic_fetch_add(F.ctl + CW_CNT + layer * 2048 + 1024 + F.tid * 16, n, RLX_AGENT) : 0u; }
    __syncthreads();
    if (act) { const int d1 = pstart[e1] + (int)(lbase[e1] + s1), d2 = pstart[e2] + (int)(lbase[e2] + s2);
        *(v2u*)(TOK + row * 8 + 4) = (v2u){(unsigned)d1, (unsigned)d2};
        SROW[d1] = (int)row; SROW[d2] = (int)row; RS[d1] = rst; RS[d2] = rst; }
    __syncthreads();
}
__device__ __forceinline__ void moe_range(const LAS unsigned char* lds, int& T0, int& nun) { const int nt = *(const LAS int*)(lds + MOE_NTILE), x = (int)blockIdx.x & 7;
    T0 = (nt * x) >> 3; nun = (((nt * (x + 1)) >> 3) - T0) * 4; }
constexpr int MOE_RIDX = MISC_OFF + 2048;
__device__ __forceinline__ void moe_ridx(const Frame& F) {
    const int* SROW = (const int*)(F.ws + WS_SROW); LAS int* ridx = (LAS int*)(F.lds + MOE_RIDX);
    const LAS int* pstart = (const LAS int*)(F.lds + MOE_PSTART);
    const int r = (int)blockIdx.x >> 3; int T0, nun; moe_range(F.lds, T0, nun);
    if (F.tid < 256) { int v[6];
#pragma unroll
        for (int i = 0; i < 6; ++i) { const int Lx = i * 32 + r; v[i] = (Lx < nun) ? SROW[(T0 + (Lx >> 2)) * 256 + F.tid] : 0; }
#pragma unroll
        for (int i = 0; i < 6; ++i) ridx[i * 256 + F.tid] = v[i]; }
    __syncthreads();
}
constexpr int RS_TAB = MISC_OFF + 8192;
template <class Sched> __device__ __forceinline__ void rs_preload(const Frame& F, const Sched& S, const float* __restrict__ src) {
    LAS float* tab = (LAS float*)(F.lds + RS_TAB);
    if (F.tid < 256) { float v[8];
#pragma unroll
        for (int i = 0; i < 8; ++i) { pg8::Unit u; v[i] = S.next(i, u) ? src[(size_t)u.pm * 256 + F.tid] : 0.f; }
#pragma unroll
        for (int i = 0; i < 8; ++i) tab[i * 256 + F.tid] = v[i]; }
    __syncthreads();
}
struct MoeOrder {
    const LAS int* texp; int T0, nun, r; unsigned* dep; bool samex;
    __device__ __forceinline__ void signal(int pm) const { if (threadIdx.x == 0) { if (samex) __hip_atomic_fetch_add(dep + pm * 16, 1u, __ATOMIC_RELAXED, __HIP_MEMORY_SCOPE_AGENT);
                                                                                    else __hip_atomic_fetch_add(dep + pm * 16, 1u, __ATOMIC_RELEASE, __HIP_MEMORY_SCOPE_AGENT); } }
    __device__ __forceinline__ void init(const LAS unsigned char* lds) { const LAS int* pstart = (const LAS int*)(lds + MOE_PSTART); texp = (const LAS int*)(lds + MOE_TEXP);
        r = (int)blockIdx.x >> 3; moe_range(lds, T0, nun); }
    __device__ __forceinline__ bool next(int i, pg8::Unit& u) const { const int Lx = i * 32 + r; if (Lx >= nun) return false; const int rt = T0 + (Lx >> 2); u.pm = rt; u.pn = texp[rt] * 4 + (Lx & 3); u.ord = i; return true; }
    __device__ __forceinline__ void a_ready(const pg8::Unit&) const {}
    __device__ __forceinline__ void done(const pg8::Unit&) const {}
};
constexpr int MOE_DLIST = MISC_OFF + 1440;
struct MoeDownOrder {
    const LAS int* texp; const LAS int* dl; int T0, nun; unsigned* dep; mutable int have;
    __device__ __forceinline__ void init(LAS unsigned char* lds, unsigned* dep_) { const LAS int* pstart = (const LAS int*)(lds + MOE_PSTART); texp = (const LAS int*)(lds + MOE_TEXP); dep = dep_; have = -1;
        const int r = (int)blockIdx.x >> 3, tid = (int)threadIdx.x; moe_range(lds, T0, nun);
        LAS int* cl = (LAS int*)(lds + MOE_DLIST); LAS int* dlw = cl + 32; dl = dlw;
        const int target = (3 * nun + 31) / 32;
        if (tid < 32) { const int nup = tid < nun ? (nun - tid + 31) / 32 : 0; cl[tid] = target > 2 * nup ? target - 2 * nup : 0; }
        __syncthreads();
        if (tid < 24) { int base = 0, off = 0;
            for (int rr = 0; rr < 32; ++rr) { const int c = cl[rr]; base += c < tid ? c : tid; off += (rr < r && c > tid) ? 1 : 0; }
            const int Lx = base + off; dlw[tid] = (tid < cl[r] && Lx < nun) ? Lx : -1; }
        if (tid == 0) { __builtin_amdgcn_fence(__ATOMIC_ACQUIRE, "agent"); asm volatile("s_waitcnt vmcnt(0)" ::: "memory"); }
        __syncthreads(); }
    __device__ __forceinline__ bool next(int i, pg8::Unit& u) const { if (i >= 24) return false; const int Lx = dl[i]; if (Lx < 0) return false; const int rt = T0 + (Lx >> 2); u.pm = rt; u.pn = texp[rt] * 4 + (Lx & 3); u.ord = i; return true; }
    __device__ __forceinline__ void a_ready(const pg8::Unit& u) const {
        if (u.pm != have) {
            if (threadIdx.x == 0) { int spin = 0; while (__hip_atomic_load(dep + u.pm * 16, __ATOMIC_RELAXED, __HIP_MEMORY_SCOPE_AGENT) < 4u && ++spin < (1 << 24)) __builtin_amdgcn_s_sleep(2);
                asm volatile("" ::: "memory"); }
            __builtin_amdgcn_s_barrier();
            have = u.pm; }
    }
    __device__ __forceinline__ void done(const pg8::Unit&) const {}
};
constexpr int HG_TS = 288;
constexpr int HG_RS = 272;
template <int SH> __device__ __forceinline__ float row_shr(float x) {
    return __builtin_bit_cast(float, __builtin_amdgcn_update_dpp(0, __builtin_bit_cast(int, x), 0x110 + SH, 0xF, 0xF, true)); }
__device__ __forceinline__ float row_scan16(float x) { x += row_shr<1>(x); x += row_shr<2>(x); x += row_shr<4>(x); x += row_shr<8>(x); return x; }

struct HgLf { f32x4 a[4], c[4]; };
__device__ __forceinline__ void hg_load_lf(const float* __restrict__ lfrow, int g, HgLf& R) {
#pragma unroll
    for (int st = 0; st < 4; ++st) { R.a[st] = *(const f32x4*)(lfrow + 32 * st + 8 * g); R.c[st] = *(const f32x4*)(lfrow + 32 * st + 8 * g + 4); }
}
__device__ __forceinline__ void hg_scan_vals(const HgLf& R, LAS float* tot, int w, int t, int g, float (&kk)[4][8], float (&bl)[4][8]) {
#pragma unroll
    for (int st = 0; st < 4; ++st) { const f32x4 a = R.a[st], c = R.c[st];
        const float lf[8] = {a.x, a.y, a.z, a.w, c.x, c.y, c.z, c.w};
#pragma unroll
        for (int j = 0; j < 8; ++j) { kk[st][j] = 1.f - fexp(lf[j]); bl[st][j] = row_scan16(lf[j]); }
        if (t == 15) { *(LAS f32x4*)(tot + w * 128 + 32 * st + 8 * g) = (f32x4){bl[st][0], bl[st][1], bl[st][2], bl[st][3]};
                       *(LAS f32x4*)(tot + w * 128 + 32 * st + 8 * g + 4) = (f32x4){bl[st][4], bl[st][5], bl[st][6], bl[st][7]}; } }
}
__device__ __forceinline__ void hg_scan(const float* __restrict__ lfrow, LAS float* tot, int w, int t, int g, float (&kk)[4][8], float (&bl)[4][8]) {
    HgLf R; hg_load_lf(lfrow, g, R); hg_scan_vals(R, tot, w, t, g, kk, bl); }
__device__ __forceinline__ void lds_row8(const LAS float* p, float (&v)[8]) { const f32x4 a = *(const LAS f32x4*)p, c = *(const LAS f32x4*)(p + 4);
    v[0] = a.x; v[1] = a.y; v[2] = a.z; v[3] = a.w; v[4] = c.x; v[5] = c.y; v[6] = c.z; v[7] = c.w; }
__device__ __forceinline__ void hg_stage_v(const Frame& F, const bf16* __restrict__ vsrc, LAS unsigned char* img) {
#pragma unroll
    for (int p = 0; p < 4; ++p) { const int idx = F.tid + 512 * p, row = idx >> 4, c16 = idx & 15;
        *(LAS v4u*)(img + row * HG_TS + c16 * 16) = *(const v4u*)(vsrc + (size_t)row * DM + 8 * c16); }
}

constexpr int A1_KT = 0, A1_V = 128 * HG_TS, A1_TOT = 2 * 128 * HG_TS;
struct A1Pre { HgLf lf; v4u v[4]; };
__device__ __forceinline__ void hg_a1_prefetch(const Frame& F, int bh, int c, A1Pre& P) {
    const int w = F.wave, t = F.lane & 15, g = F.lane >> 4, b = bh >> 3, hd = bh & 7;
    const size_t row0 = (size_t)b * LP + 128 * c;
    hg_load_lf((const float*)(F.ws + WS_LOGF) + (row0 + 16 * w + t) * DM + hd * HK, g, P.lf);
    const bf16* vsrc = (const bf16*)(F.ws + WS_V) + row0 * DM + hd * HV;
#pragma unroll
    for (int p = 0; p < 4; ++p) { const int idx = F.tid + 512 * p, row = idx >> 4, c16 = idx & 15; P.v[p] = *(const v4u*)(vsrc + (size_t)row * DM + 8 * c16); }
}
__device__ __forceinline__ void hg_a1_unit(const Frame& F, int bh, int c, const A1Pre& P) {
    const int w = F.wave, t = F.lane & 15, g = F.lane >> 4;
    LAS unsigned char* L = F.lds; LAS float* tot = (LAS float*)(L + A1_TOT);
    float kk[4][8], bl[4][8];
#pragma unroll
    for (int p = 0; p < 4; ++p) { const int idx = F.tid + 512 * p, row = idx >> 4, c16 = idx & 15; *(LAS v4u*)(L + A1_V + row * HG_TS + c16 * 16) = P.v[p]; }
    hg_scan_vals(P.lf, tot, w, t, g, kk, bl);
}
__device__ __forceinline__ void hg_a1_rest(const Frame& F, int bh, int c, float (&kk)[4][8], float (&bl)[4][8]) {
    const int w = F.wave, t = F.lane & 15, g = F.lane >> 4;
    LAS unsigned char* L = F.lds; LAS float* tot = (LAS float*)(L + A1_TOT);
    __syncthreads();
#pragma unroll
    for (int st = 0; st < 4; ++st) { float e[8]; lds_row8(tot + w * 128 + 32 * st + 8 * g, e);
        for (int ww = w + 1; ww < 8; ++ww) { float x[8]; lds_row8(tot + ww * 128 + 32 * st + 8 * g, x);
#pragma unroll
            for (int j = 0; j < 8; ++j) e[j] += x[j]; }
        v4u o; float r[8];
#pragma unroll
        for (int j = 0; j < 8; ++j) r[j] = kk[st][j] * fexp(e[j] - bl[st][j]);
        o.x = pk2(r[0], r[1]); o.y = pk2(r[2], r[3]); o.z = pk2(r[4], r[5]); o.w = pk2(r[6], r[7]);
        *(LAS v4u*)(L + A1_KT + (16 * w + t) * HG_TS + (32 * st + 8 * g) * 2) = o; }
    if (F.tid < 128) { float s = 0.f;
#pragma unroll
        for (int ww = 0; ww < 8; ++ww) s += tot[ww * 128 + F.tid];
        ((float*)(F.ws + WS_BE))[(size_t)(bh * 128 + c) * 128 + F.tid] = s; }
    __syncthreads();
    f32x4 acc[8];
#pragma unroll
    for (int kb = 0; kb < 8; ++kb) acc[kb] = (f32x4){0.f, 0.f, 0.f, 0.f};
    const int i16 = F.lane & 15;
    const LAS unsigned char* ap = L + A1_V + (8 * g + (i16 >> 2)) * HG_TS + (16 * w + 4 * (i16 & 3)) * 2;
    const LAS unsigned char* bp = L + A1_KT + (8 * g + (i16 >> 2)) * HG_TS + (4 * (i16 & 3)) * 2;
#pragma unroll
    for (int ts = 0; ts < 4; ++ts) {
        const bf16x4 a0 = vtr(ap + 32 * ts * HG_TS), a1 = vtr(ap + (32 * ts + 4) * HG_TS);
        const bf16x8 af = (bf16x8){a0[0], a0[1], a0[2], a0[3], a1[0], a1[1], a1[2], a1[3]};
#pragma unroll
        for (int kb = 0; kb < 8; ++kb) { const bf16x4 b0 = vtr(bp + 32 * ts * HG_TS + 32 * kb), b1 = vtr(bp + (32 * ts + 4) * HG_TS + 32 * kb);
            const bf16x8 bfr = (bf16x8){b0[0], b0[1], b0[2], b0[3], b1[0], b1[1], b1[2], b1[3]};
            acc[kb] = __builtin_amdgcn_mfma_f32_16x16x32_bf16(af, bfr, acc[kb], 0, 0, 0); }
    }
    float* S = (float*)(F.ws + WS_SLOC) + (size_t)(bh * 128 + c) * (HV * HK);
#pragma unroll
    for (int kb = 0; kb < 8; ++kb)
#pragma unroll
        for (int r = 0; r < 4; ++r) S[(16 * w + 4 * g + r) * HK + 16 * kb + i16] = acc[kb][r];
    __syncthreads();
}
__device__ __forceinline__ void hg_a1_phase(const Frame& F) {
    int id = F.vcu; if (id >= 16 * 128) return;
    A1Pre P; hg_a1_prefetch(F, id >> 7, id & 127, P);
    for (;;) {
        __builtin_amdgcn_s_waitcnt(0x0F70);
        float kk[4][8], bl[4][8];
        { const int w = F.wave, t = F.lane & 15, g = F.lane >> 4; LAS unsigned char* L = F.lds;
#pragma unroll
            for (int p = 0; p < 4; ++p) { const int idx = F.tid + 512 * p, row = idx >> 4, c16 = idx & 15; *(LAS v4u*)(L + A1_V + row * HG_TS + c16 * 16) = P.v[p]; }
            hg_scan_vals(P.lf, (LAS float*)(L + A1_TOT), w, t, g, kk, bl); }
        const int idn = id + F.G;
        if (idn < 16 * 128) hg_a1_prefetch(F, idn >> 7, idn & 127, P);
        hg_a1_rest(F, id >> 7, id & 127, kk, bl);
        id = idn; if (id >= 16 * 128) break;
    }
}
__device__ __forceinline__ void hg_a2_phase(const Frame& F) {
    const int gt = blockIdx.x * 256 + (F.tid & 255), bh = (blockIdx.x * 256) >> 12;
    LAS float* bel = (LAS float*)F.lds;
    { const float* BE = (const float*)(F.ws + WS_BE) + (size_t)bh * 128 * 128;
        f32x4 v[8];
#pragma unroll
        for (int j = 0; j < 8; ++j) v[j] = *(const f32x4*)(BE + 4 * (F.tid + 512 * j));
#pragma unroll
        for (int j = 0; j < 8; ++j) *(LAS f32x4*)(bel + 4 * (F.tid + 512 * j)) = v[j]; }
    __syncthreads();
    if (F.tid < 256) {
        const int kq = gt & 31, dv = (gt >> 5) & 127;
        const float* S = (const float*)(F.ws + WS_SLOC) + (size_t)bh * 128 * (HV * HK) + dv * HK + 4 * kq;
        bf16* ST = (bf16*)(F.ws + WS_ST) + (size_t)bh * 129 * (HV * HK) + dv * HK + 4 * kq;
        f32x4 st = (f32x4){0.f, 0.f, 0.f, 0.f};
        f32x4 A[8], B[8];
#pragma unroll
        for (int j = 0; j < 8; ++j) A[j] = *(const f32x4*)(S + (size_t)j * (HV * HK));
#define A2_BATCH(CUR, NXT, nb) do { __builtin_amdgcn_s_waitcnt(0x0F70); \
        if ((nb) + 1 < 16) { _Pragma("unroll") for (int j = 0; j < 8; ++j) NXT[j] = *(const f32x4*)(S + (size_t)(8 * ((nb) + 1) + j) * (HV * HK)); } \
        _Pragma("unroll") for (int j = 0; j < 8; ++j) { const int c = 8 * (nb) + j; \
            *(v2u*)(ST + (size_t)c * (HV * HK)) = (v2u){pk2(st.x, st.y), pk2(st.z, st.w)}; \
            const f32x4 be = *(const LAS f32x4*)(bel + c * 128 + 4 * kq), s = CUR[j]; \
            st.x = fexp(be.x) * st.x + s.x; st.y = fexp(be.y) * st.y + s.y; st.z = fexp(be.z) * st.z + s.z; st.w = fexp(be.w) * st.w + s.w; } } while (0)
        for (int nb = 0; nb < 16; nb += 2) { A2_BATCH(A, B, nb); A2_BATCH(B, A, nb + 1); }
#undef A2_BATCH
        *(v2u*)(ST + (size_t)128 * (HV * HK)) = (v2u){pk2(st.x, st.y), pk2(st.z, st.w)};
    }
    __syncthreads();
}
constexpr int A3_KH = 0, A3_V = 128 * HG_RS, A3_ST = A3_V + 128 * HG_TS, A3_TOT = A3_ST + 128 * HG_RS, A3_ET = A3_TOT + 4096, A3_STG = 0, A3_STG_W = 16 * 528;
__device__ __forceinline__ void hg_a3_unit(const Frame& F, int bh, int c) {
    const int w = (F.wave & 1) ? 7 - (F.wave >> 1) : (F.wave >> 1), t = F.lane & 15, g = F.lane >> 4, b = bh >> 3, hd = bh & 7;
    const size_t row0 = (size_t)b * LP + 128 * c;
    LAS unsigned char* L = F.lds; LAS float* tot = (LAS float*)(L + A3_TOT);
    float kk[4][8], bl[4][8];
    hg_stage_v(F, (const bf16*)(F.ws + WS_V) + row0 * DM + hd * HV, L + A3_V);
    { const bf16* ssrc = (const bf16*)(F.ws + WS_ST) + (size_t)(bh * 129 + c) * (HV * HK);
#pragma unroll
        for (int p = 0; p < 4; ++p) { const int idx = F.tid + 512 * p, row = idx >> 4, c16 = idx & 15;
            *(LAS v4u*)(L + A3_ST + row * HG_RS + c16 * 16) = *(const v4u*)(ssrc + (size_t)row * HK + 8 * c16); } }
    hg_scan((const float*)(F.ws + WS_LOGF) + (row0 + 16 * w + t) * DM + hd * HK, tot, w, t, g, kk, bl);
    LAS float* etab = (LAS float*)(L + A3_ET);
    if (t == 15) {
#pragma unroll
        for (int st = 0; st < 4; ++st) { *(LAS f32x4*)(etab + w * 128 + 32 * st + 8 * g) = (f32x4){fexp(bl[st][0]), fexp(bl[st][1]), fexp(bl[st][2]), fexp(bl[st][3])};
            *(LAS f32x4*)(etab + w * 128 + 32 * st + 8 * g + 4) = (f32x4){fexp(bl[st][4]), fexp(bl[st][5]), fexp(bl[st][6]), fexp(bl[st][7])}; } }
    float qd[4][8];
    { const bf16* qrow = (const bf16*)(F.ws + WS_Q) + (row0 + 16 * w + t) * DM + hd * HK;
#pragma unroll
        for (int st = 0; st < 4; ++st) { const v4u u = *(const v4u*)(qrow + 32 * st + 8 * g);
            const float q[8] = {bflo(u.x), bfhi(u.x), bflo(u.y), bfhi(u.y), bflo(u.z), bfhi(u.z), bflo(u.w), bfhi(u.w)};
            float e[8]; lds_row8(tot + w * 128 + 32 * st + 8 * g, e);
            v4u o; float r[8];
#pragma unroll
            for (int j = 0; j < 8; ++j) { r[j] = kk[st][j] * fexp(e[j] - bl[st][j]); qd[st][j] = q[j] * fexp(bl[st][j]); }
            o.x = pk2(r[0], r[1]); o.y = pk2(r[2], r[3]); o.z = pk2(r[4], r[5]); o.w = pk2(r[6], r[7]);
            *(LAS v4u*)(L + A3_KH + (16 * w + t) * HG_RS + (32 * st + 8 * g) * 2) = o; } }
    __syncthreads();
    v4u gpre[4];
    { const int rr = F.lane >> 2, seg = F.lane & 3; const bf16* gs = (const bf16*)(F.ws + WS_K) + (row0 + 16 * w + rr) * DM + hd * HV + 32 * seg;
#pragma unroll
        for (int q = 0; q < 4; ++q) gpre[q] = *(const v4u*)(gs + 8 * q); }
    f32x4 o[8];
#pragma unroll
    for (int d = 0; d < 8; ++d) o[d] = (f32x4){0.f, 0.f, 0.f, 0.f};
    const int i16 = F.lane & 15;
    {
        bf16x8 aq[4];
#pragma unroll
        for (int st = 0; st < 4; ++st) { float e[8];
#pragma unroll
            for (int j = 0; j < 8; ++j) e[j] = 0.f;
            for (int ww = 0; ww < w; ++ww) { float x[8]; lds_row8(tot + ww * 128 + 32 * st + 8 * g, x);
#pragma unroll
                for (int j = 0; j < 8; ++j) e[j] += x[j]; }
            v4u pk; pk.x = pk2(qd[st][0] * fexp(e[0]), qd[st][1] * fexp(e[1])); pk.y = pk2(qd[st][2] * fexp(e[2]), qd[st][3] * fexp(e[3]));
            pk.z = pk2(qd[st][4] * fexp(e[4]), qd[st][5] * fexp(e[5])); pk.w = pk2(qd[st][6] * fexp(e[6]), qd[st][7] * fexp(e[7]));
            aq[st] = __builtin_bit_cast(bf16x8, pk); }
        const LAS unsigned char* sp = L + A3_ST + i16 * HG_RS + 16 * g;
#pragma unroll
        for (int d = 0; d < 8; ++d)
#pragma unroll
            for (int st = 0; st < 4; ++st) { const bf16x8 bfr = *(const LAS bf16x8*)(sp + 16 * d * HG_RS + 64 * st);
                o[d] = __builtin_amdgcn_mfma_f32_16x16x32_bf16(aq[st], bfr, o[d], 0, 0, 0); }
    }
    {
        float dsc[4][8];
#pragma unroll
        for (int st = 0; st < 4; ++st) { float x[8]; lds_row8(tot + w * 128 + 32 * st + 8 * g, x);
#pragma unroll
            for (int j = 0; j < 8; ++j) dsc[st][j] = fexp(fminf(-x[j], 85.f)); }
        const LAS unsigned char* kp = L + A3_KH + i16 * HG_RS + 16 * g;
        const LAS unsigned char* vp = L + A3_V + (4 * g + (i16 >> 2)) * HG_TS + (4 * (i16 & 3)) * 2;
        for (int j = w; j >= 0; --j) {
            f32x4 pt = (f32x4){0.f, 0.f, 0.f, 0.f};
#pragma unroll
            for (int st = 0; st < 4; ++st) {
                v4u pk; pk.x = pk2(qd[st][0] * dsc[st][0], qd[st][1] * dsc[st][1]); pk.y = pk2(qd[st][2] * dsc[st][2], qd[st][3] * dsc[st][3]);
                pk.z = pk2(qd[st][4] * dsc[st][4], qd[st][5] * dsc[st][5]); pk.w = pk2(qd[st][6] * dsc[st][6], qd[st][7] * dsc[st][7]);
                const bf16x8 kf = *(const LAS bf16x8*)(kp + 16 * j * HG_RS + 64 * st);
                pt = __builtin_amdgcn_mfma_f32_16x16x32_bf16(kf, __builtin_bit_cast(bf16x8, pk), pt, 0, 0, 0); }
            if (j == w) {
#pragma unroll
                for (int r = 0; r < 4; ++r) if (4 * g + r > i16) pt[r] = 0.f; }
            const v2u pp = (v2u){pk2(pt[0], pt[1]), pk2(pt[2], pt[3])};
            const bf16x4 pa = __builtin_bit_cast(bf16x4, pp);
#pragma unroll
            for (int d = 0; d < 8; ++d) { const bf16x4 vb = vtr(vp + 16 * j * HG_TS + 32 * d);
                o[d] = __builtin_amdgcn_mfma_f32_16x16x16bf16_1k(pa, vb, o[d], 0, 0, 0); }
            if (j == w) {
#pragma unroll
                for (int st = 0; st < 4; ++st)
#pragma unroll
                    for (int jj = 0; jj < 8; ++jj) dsc[st][jj] = 1.f;
            } else {
#pragma unroll
                for (int st = 0; st < 4; ++st) { float x[8]; lds_row8(etab + j * 128 + 32 * st + 8 * g, x);
#pragma unroll
                    for (int jj = 0; jj < 8; ++jj) dsc[st][jj] *= x[jj]; } }
        }
    }
    float rs[4];
#pragma unroll
    for (int r = 0; r < 4; ++r) { float s = 0.f;
#pragma unroll
        for (int d = 0; d < 8; ++d) s += o[d][r] * o[d][r];
        s += __shfl_xor(s, 1); s += __shfl_xor(s, 2); s += __shfl_xor(s, 4); s += __shfl_xor(s, 8);
        rs[r] = __builtin_amdgcn_rsqf(s * (1.f / HV) + EPS); }
    const float* go = F.in[I_HG_ON];
    __syncthreads();
    LAS float* stg = (LAS float*)(L + A3_STG + w * A3_STG_W);
#pragma unroll
    for (int d = 0; d < 8; ++d) { const float gv = go[16 * d + i16];
#pragma unroll
        for (int r = 0; r < 4; ++r) stg[(4 * g + r) * 132 + 16 * d + i16] = o[d][r] * rs[r] * gv; }
    asm volatile("s_waitcnt lgkmcnt(0)" ::: "memory");
    __builtin_amdgcn_wave_barrier();
    { const int rr = F.lane >> 2, seg = F.lane & 3; const size_t orow = (row0 + 16 * w + rr) * DM + hd * HV + 32 * seg;
        const bf16* gs = (const bf16*)(F.ws + WS_K) + orow; bf16* og = (bf16*)(F.ws + WS_OG) + orow;
#pragma unroll
        for (int q = 0; q < 4; ++q) { const v4u gu = gpre[q]; float x[8]; lds_row8(stg + rr * 132 + 32 * seg + 8 * q, x);
            v4u ou; ou.x = pk2(x[0] * bflo(gu.x), x[1] * bfhi(gu.x)); ou.y = pk2(x[2] * bflo(gu.y), x[3] * bfhi(gu.y));
            ou.z = pk2(x[4] * bflo(gu.z), x[5] * bfhi(gu.z)); ou.w = pk2(x[6] * bflo(gu.w), x[7] * bfhi(gu.w));
            *(v4u*)(og + 8 * q) = ou; } }
    __syncthreads();
}
__device__ __forceinline__ void hg_a3_phase(const Frame& F) {
    for (int i = 0;; ++i) { const int id = i * F.G + F.vcu; if (id >= 16 * 129) break;
        if (id < 16 * 128) hg_a3_unit(F, id >> 7, id & 127); else hg_a3_unit(F, id - 16 * 128, 128); }
}
constexpr int NPHASE = 21;
struct Args { const float* in[21]; float* out; unsigned char* ws; int ph_lo, ph_hi, li, pad; };
__global__ void __launch_bounds__(512, 2) hybrid_fwd(Args args) {
    extern __shared__ __attribute__((aligned(16))) unsigned char lds_raw[];
    Frame F;
    F.lds = (LAS unsigned char*)lds_raw; F.ws = args.ws; F.ctl = (unsigned*)(args.ws + WS_CTL);
    F.tid = threadIdx.x; F.lane = F.tid & 63; F.wave = __builtin_amdgcn_readfirstlane(F.tid >> 6);
    F.G = gridDim.x; { const int bx = blockIdx.x; F.vcu = (F.G % 8 == 0) ? (bx % 8) * (F.G / 8) + bx / 8 : bx; }
#pragma unroll
    for (int i = 0; i < 21; ++i) F.in[i] = args.in[i];
    F.out = args.out;
    for (int u = F.tid; u < (LDS_BYTES - MISC_OFF) / 4; u += 512) ((LAS unsigned*)(F.lds + MISC_OFF))[u] = 0u;
    __syncthreads();
    XcdBarrier bar = xcd_barrier_post(F.ctl + CW_BAR + args.li * XCD_BAR_WORDS, (volatile LAS unsigned*)(F.lds + MISC_OFF));
    if (F.tid == 0) __hip_atomic_fetch_or(F.ctl + CW_XMAP + args.li * 128 + ((int)blockIdx.x & 7) * 16, 1u << bar.x, __ATOMIC_RELAXED, __HIP_MEMORY_SCOPE_AGENT);
    int nbar = 0;
    const int lo = args.ph_lo, hi = args.ph_hi;
#define IN(k) (lo <= (k) && (k) < hi)
#define SEAM(k) do { if (IN(k) && IN((k) + 1)) { xcd_barrier(bar); nbar = 1; } } while (0)
    unsigned char* ws = F.ws;
    bf16* H = (bf16*)(ws + WS_H); const float* RSTD = (const float*)(ws + WS_RSTD);
    bf16* WSM = (bf16*)(ws + WS_WSM);

    if (IN(0)) { p0_prologue(F); } SEAM(0);
    if (IN(1)) { t_phase<0, 1, 1, false>(F, F.in[I_FOX_NORM], WSM, WSM + 16384, 0); } SEAM(1);
    if (IN(2)) { fox_scan(F); skinny_gemm<0>(F, H, (const bf16*)(ws + WS_WQKV), 3 * DM);
        pg8::Gemm g{H, (const bf16*)(ws + WS_WQKV), MP, 3 * DM, DM}; MainOrder S; S.init(3 * DM, F.G, (int)blockIdx.x);
        rs_preload(F, S, RSTD); EpiQKV E{(bf16*)(ws + WS_Q), F.in[I_FOX_QN], F.in[I_FOX_KN], (const LAS float*)(F.lds + RS_TAB)};
        pg8::gemm_phase<EpiQKV, MainOrder, true, true>(F.lds, g, S, E); } SEAM(2);
    if (IN(3)) { const bool first = (F.vcu & 1) != 0; if (first) p0_moe_weights(F); __syncthreads(); attn_phase(F); __syncthreads(); if (!first) p0_moe_weights(F); } SEAM(3);
    if (IN(4)) { skinny_gemm<2>(F, (const bf16*)(ws + WS_Q), (const bf16*)(ws + WS_WFO), DM);
        pg8::Gemm g{(const bf16*)(ws + WS_Q), (const bf16*)(ws + WS_WFO), MP, DM, DM}; MainOrder S; S.init(DM, F.G, (int)blockIdx.x);
        EpiResid E{H}; pg8::gemm_phase<EpiResid, MainOrder, true, true>(F.lds, g, S, E); } SEAM(4);
#define MOE_PHASES(layer, pb) \
    if (IN(pb)) { const bf16* wh = WSM + 32768 + (size_t)(layer) * 98304; t_phase<1, 3, 2, false>(F, F.in[I_MOE_NORM] + (layer) * DM, wh, wh + 49152, (layer)); } SEAM(pb); \
    if (IN((pb) + 1)) { moe_gather(F, (layer)); } SEAM((pb) + 1); \
    if (IN((pb) + 2)) { moe_tables(F, (layer)); moe_ridx(F); \
        MoeOrder S; S.init(F.lds); S.dep = F.ctl + CW_DEP + (layer) * 8192; \
        { const unsigned xm = __hip_atomic_load(F.ctl + CW_XMAP + args.li * 128 + ((int)blockIdx.x & 7) * 16, __ATOMIC_RELAXED, __HIP_MEMORY_SCOPE_AGENT); S.samex = nbar > 0 && __builtin_popcount(xm) == 1; } \
        pg8::Gemm g{H, (const bf16*)(ws + WS_WUP) + (size_t)(layer) * NEXP * DM * DM, 0, 0, DM}; \
        rs_preload(F, S, (const float*)(ws + WS_RS)); EpiUp E{(bf16*)(ws + WS_ACT), (const LAS float*)(F.lds + RS_TAB)}; pg8::gemm_phase_g<EpiUp, MoeOrder>(F.lds, g, S, E, (const LAS int*)(F.lds + MOE_RIDX)); \
        MoeDownOrder SD; SD.init(F.lds, F.ctl + CW_DEP + (layer) * 8192); \
        pg8::Gemm g2{(const bf16*)(ws + WS_ACT), (const bf16*)(ws + WS_WDN) + (size_t)(layer) * NEXP * DM * DEXP, 0, 0, DEXP}; \
        EpiDown E2{(bf16*)(ws + WS_XPAD)}; pg8::gemm_phase<EpiDown, MoeDownOrder, true, true>(F.lds, g2, SD, E2); } \
    SEAM((pb) + 3);
    MOE_PHASES(0, 5)
    if (IN(9)) { t_phase<2, 0, 0, false>(F, F.in[I_HG_NORM], nullptr, nullptr, 0); } SEAM(9);
    if (IN(10)) { skinny_gemm<3>(F, H, (const bf16*)(ws + WS_WHI), 4 * DM);
        pg8::Gemm g{H, (const bf16*)(ws + WS_WHI), MP, 4 * DM, DM}; MainOrder S; S.init(4 * DM, F.G, (int)blockIdx.x);
        rs_preload(F, S, RSTD); EpiHgIn E{(bf16*)(ws + WS_Q), (float*)(ws + WS_LOGF), F.in[I_HG_BF], F.in[I_HG_LB], (const LAS float*)(F.lds + RS_TAB)};
        pg8::gemm_phase<EpiHgIn, MainOrder, true, true>(F.lds, g, S, E); } SEAM(10);
    if (IN(11)) { hg_a1_phase(F); } SEAM(11);
    if (IN(12)) { hg_a2_phase(F); } SEAM(12);
    if (IN(13)) { hg_a3_phase(F); } SEAM(13);
    if (IN(14)) { skinny_gemm<2>(F, (const bf16*)(ws + WS_OG), (const bf16*)(ws + WS_WHO), DM);
        pg8::Gemm g{(const bf16*)(ws + WS_OG), (const bf16*)(ws + WS_WHO), MP, DM, DM}; MainOrder S; S.init(DM, F.G, (int)blockIdx.x);
        EpiResid E{H}; pg8::gemm_phase<EpiResid, MainOrder, true, true>(F.lds, g, S, E); } SEAM(14);
    MOE_PHASES(1, 15)
    if (IN(19)) { t_phase<2, 0, 0, true>(F, nullptr, nullptr, nullptr, 0); }
    if (IN(20)) { t_phase<1, 0, 0, true>(F, nullptr, nullptr, nullptr, 0); }
    if (lo == 26) {
        const unsigned* TOK = (const unsigned*)(ws + WS_TOK); const bf16* Y = (const bf16*)(ws + WS_XPAD);
        for (size_t i = (size_t)blockIdx.x * 512 + F.tid; i < (size_t)NBATCH * SEQ * DM; i += (size_t)F.G * 512) {
            const size_t rr = i >> 10; const int c = (int)(i & 1023); const size_t b = rr / SEQ, t = rr % SEQ + NMETA; const size_t row = b * LP + t;
            F.out[i] = c < 512 ? 10.f * __builtin_bit_cast(float, TOK[row * 8 + 1]) : 10.f * __builtin_bit_cast(float, TOK[row * 8 + 2]); }
    }
    if (lo == 25) {
        const float* src = (const float*)(ws + WS_CC);
        for (size_t i = (size_t)blockIdx.x * 512 + F.tid; i < (size_t)NBATCH * SEQ * DM; i += (size_t)F.G * 512) {
            const size_t rr = i >> 10; const int c = (int)(i & 1023); const size_t b = rr / SEQ, t = rr % SEQ + NMETA;
            F.out[i] = src[(b * FH + (c & 15)) * LP + t] + (c >= 16 ? 1.0f : 0.f); }
    }
    if (lo >= 21 && lo <= 24) {
        const bf16* src = (const bf16*)(ws + (lo == 21 ? WS_Q : lo == 22 ? WS_K : lo == 23 ? WS_V : WS_XN));
        for (size_t i = (size_t)blockIdx.x * 512 + F.tid; i < (size_t)NBATCH * SEQ * DM; i += (size_t)F.G * 512) {
            const size_t rr = i >> 10; const int c = (int)(i & 1023); const size_t b = rr / SEQ, t = rr % SEQ + NMETA;
            F.out[i] = bf2f(src[(b * LP + t) * DM + c]); }
    }
#undef IN
#undef SEAM
}

extern "C" void kernel_launch(void* const* d_in, const int* in_sizes, int n_in, void* d_out, int out_size, void* d_ws, size_t ws_size, hipStream_t stream) {
    static int grid = 0;
    if (grid == 0) {
        if (n_in != 21 || out_size != NBATCH * SEQ * DM || ws_size < WS_END) { fprintf(stderr, "kernel_launch: unexpected shapes (n_in %d out %d ws %zu)\n", n_in, out_size, ws_size); grid = -1; return; }
        int dev = 0, cus = 0, per_cu = 0;
        if (hipGetDevice(&dev) != hipSuccess || hipDeviceGetAttribute(&cus, hipDeviceAttributeMultiprocessorCount, dev) != hipSuccess) { grid = -1; return; }
        if (hipFuncSetAttribute((const void*)hybrid_fwd, hipFuncAttributeMaxDynamicSharedMemorySize, LDS_BYTES) != hipSuccess) { fprintf(stderr, "kernel_launch: hipFuncSetAttribute failed\n"); grid = -1; return; }
        if (hipOccupancyMaxActiveBlocksPerMultiprocessor(&per_cu, (const void*)hybrid_fwd, 512, LDS_BYTES) != hipSuccess || per_cu < 1) { fprintf(stderr, "kernel_launch: occupancy query says %d\n", per_cu); }
        (void)hipGetLastError();
        grid = 256;
        if (cus < 256) fprintf(stderr, "kernel_launch: %d CUs < 256: the grid cannot be co-resident\n", cus);
    }
    if (grid < 0) return;
    if (hipMemsetAsync((char*)d_ws + WS_CTL, 0, CTL_ZERO_BYTES, stream) != hipSuccess) return;
    Args a{};
    for (int i = 0; i < 21; ++i) a.in[i] = (const float*)d_in[i];
    a.out = (float*)d_out; a.ws = (unsigned char*)d_ws; a.pad = 0;
#if defined(DEV_PLAN)
    static const int plan[] = { DEV_PLAN };
    int li = 0;
    for (int p : plan) { a.ph_lo = p; a.ph_hi = p + 1; a.li = li++; hipLaunchKernelGGL(hybrid_fwd, dim3(grid), dim3(512), LDS_BYTES, stream, a); }
#else
    a.ph_lo = 0; a.ph_hi = 20; a.li = 0;
    hipLaunchKernelGGL(hybrid_fwd, dim3(grid), dim3(512), LDS_BYTES, stream, a);
#endif
}
```
